# Optimizing an MI355X kernel written in HIP

```python
import jax, jax.numpy as jnp
from jax import lax
import numpy as np

D_MODEL = 1024
BATCH = 8
SEQ = 2048
DEPTH = 1
DEC_BATCH = 128
DEC_SEQ = 1
PAST_LEN = 16384
PAGE_SIZE = 128

N_META = 16
MIX_WIDTH = D_MODEL
HG_WIDTH = MIX_WIDTH // 2
HG_HEADS = 4
HG_DK = HG_WIDTH // HG_HEADS
HG_DV = HG_WIDTH // HG_HEADS
CV_WIDTH = MIX_WIDTH - HG_WIDTH
CONV_K = 31
D_FF = 4 * D_MODEL
CHUNK = 64
EPS = 1e-6
IN_COLS = 4 * HG_WIDTH + 2 * CV_WIDTH
IN_SPLITS = (HG_WIDTH, 2 * HG_WIDTH, 3 * HG_WIDTH, 4 * HG_WIDTH, 4 * HG_WIDTH + CV_WIDTH)

kernel_name = 'hymba_hgrn2_conformer_decode_step'


def _rmsnorm(x, g):
    xf = x.astype(jnp.float32)
    y = xf * lax.rsqrt(jnp.mean(xf * xf, axis=-1, keepdims=True) + EPS)
    return (y * g.astype(jnp.float32)).astype(x.dtype)


def _layernorm(x, g, b):
    xf = x.astype(jnp.float32)
    xc = xf - jnp.mean(xf, axis=-1, keepdims=True)
    y = xc * lax.rsqrt(jnp.mean(xc * xc, axis=-1, keepdims=True) + EPS)
    return (y * g.astype(jnp.float32) + b.astype(jnp.float32)).astype(x.dtype)


def _layer_lower_bound(lb_params, layer):
    p = jax.nn.softmax(lb_params.astype(jnp.float32), axis=0)
    return jnp.cumsum(p, axis=0)[layer]


def _hgrn2_chunked(q, k, v, logf, s0):
    bsz, t, h, _ = q.shape
    dv = v.shape[-1]
    n = t // CHUNK

    def blocks(a):
        return a.reshape(bsz, n, CHUNK, h, a.shape[-1]).transpose(0, 1, 3, 2, 4)

    q, k, v, logf = blocks(q), blocks(k), blocks(v), blocks(logf)
    b = jnp.cumsum(logf, axis=3)
    b_end = b[:, :, :, -1:, :]
    q_dec = q * jnp.exp(b)
    k_inv = k * jnp.exp(-b)
    k_end = k * jnp.exp(b_end - b)
    causal = jnp.tril(jnp.ones((CHUNK, CHUNK), dtype=bool))
    scores = jnp.where(causal, jnp.einsum('bnhtd,bnhsd->bnhts', q_dec, k_inv), 0.0)
    o_intra = jnp.einsum('bnhts,bnhsv->bnhtv', scores, v)
    ds = jnp.einsum('bnhsd,bnhsv->nbhdv', k_end, v)
    decay = jnp.exp(b_end[:, :, :, 0, :]).transpose(1, 0, 2, 3)

    def step(s, inp):
        dec, d = inp
        return dec[..., None] * s + d, s

    s_fin, s_start = lax.scan(step, s0, (decay, ds))
    o_inter = jnp.einsum('bnhtd,nbhdv->bnhtv', q_dec, s_start)
    o = (o_intra + o_inter).transpose(0, 1, 3, 2, 4).reshape(bsz, t, h, dv)
    return o, s_fin


def _hgrn2_recurrent(q, k, v, logf, s0):
    def step(s, inp):
        qt, kt, vt, lft = inp
        s = jnp.exp(lft)[..., None] * s + kt[..., :, None] * vt[..., None, :]
        return s, jnp.einsum('bhd,bhdv->bhv', qt, s)

    xs = tuple(a.transpose(1, 0, 2, 3) for a in (q, k, v, logf))
    s_fin, o = lax.scan(step, s0, xs)
    return o.transpose(1, 0, 2, 3), s_fin


def _layer(h, s0, buf, chunked, lb, norm1_g, w_in, hg_onorm_g, conv_w, conv_b, conv_ln_g, conv_ln_b,
           w_out, norm2_g, w_up, w_down):
    bsz, t, _ = h.shape
    f32 = jnp.float32
    hn = _rmsnorm(h, norm1_g)
    z = jnp.einsum('btd,dc->btc', hn, w_in)
    q_r, f_r, i_r, g_r, a_r, b_r = jnp.split(z, IN_SPLITS, axis=-1)

    f = lb + (1.0 - lb) * jax.nn.sigmoid(f_r.astype(f32))
    heads = lambda a: a.reshape(bsz, t, HG_HEADS, a.shape[-1] // HG_HEADS)
    q = heads(jax.nn.silu(q_r.astype(f32)))
    k = heads(1.0 - f)
    logf = heads(jnp.log(f))
    v = heads(i_r.astype(f32))
    s0 = s0.astype(f32)
    if chunked:
        front = (-N_META) % CHUNK
        back = (-(front + t)) % CHUNK
        pad = lambda a: jnp.pad(a, ((0, 0), (front, back), (0, 0), (0, 0)))
        o, s_new = _hgrn2_chunked(pad(q), pad(k), pad(v), pad(logf), s0)
        o = o[:, front:front + t]
    else:
        o, s_new = _hgrn2_recurrent(q, k, v, logf, s0)
    gate = heads(jax.nn.silu(g_r.astype(f32)))
    y_hg = (_rmsnorm(o, hg_onorm_g) * gate).reshape(bsz, t, HG_WIDTH).astype(h.dtype)

    glu = a_r * jax.nn.sigmoid(b_r)
    xcat = jnp.concatenate([buf.astype(glu.dtype), glu], axis=1)
    new_buf = xcat[:, -(CONV_K - 1):]
    dw = lax.conv_general_dilated(xcat, conv_w[:, None, :].astype(xcat.dtype), window_strides=(1,),
                                  padding='VALID', dimension_numbers=('NWC', 'WIO', 'NWC'),
                                  feature_group_count=CV_WIDTH) + conv_b
    y_cv = jax.nn.silu(_layernorm(dw, conv_ln_g, conv_ln_b)).astype(h.dtype)

    h = h + jnp.concatenate([y_hg, y_cv], axis=-1) @ w_out
    hn2 = _rmsnorm(h, norm2_g)
    h = h + jnp.square(jax.nn.relu(hn2 @ w_up)) @ w_down
    return h, s_new, new_buf


def setup_inputs(seed: int = 0) -> dict:
    key = jax.random.key(seed)
    ks = jax.random.split(key, 20)
    nrm = lambda k, shape, s: jax.random.normal(k, shape, jnp.float32) * s
    return {
        'x_prompt': nrm(ks[0], (BATCH, SEQ, D_MODEL), 1.0),
        'x_sample': nrm(ks[1], (DEC_BATCH, DEC_SEQ, D_MODEL), 1.0),
        'state_hgrn': nrm(ks[2], (DEPTH, DEC_BATCH, HG_HEADS, HG_DK, HG_DV), 0.3),
        'state_conv': nrm(ks[3], (DEPTH, DEC_BATCH, CONV_K - 1, CV_WIDTH), 0.5),
        'meta_tokens': nrm(ks[4], (N_META, D_MODEL), 1.0),
        'hg_lb': nrm(ks[5], (DEPTH + 1, HG_WIDTH), 0.1),
        'norm1_g': 1.0 + nrm(ks[6], (DEPTH, D_MODEL), 0.02),
        'w_in': nrm(ks[7], (DEPTH, D_MODEL, IN_COLS), D_MODEL ** -0.5),
        'hg_onorm_g': 1.0 + nrm(ks[8], (DEPTH, HG_DV), 0.02),
        'conv_w': nrm(ks[9], (DEPTH, CONV_K, CV_WIDTH), CONV_K ** -0.5),
        'conv_b': nrm(ks[10], (DEPTH, CV_WIDTH), 0.02),
        'conv_ln_g': 1.0 + nrm(ks[11], (DEPTH, CV_WIDTH), 0.02),
        'conv_ln_b': nrm(ks[12], (DEPTH, CV_WIDTH), 0.02),
        'w_out': nrm(ks[13], (DEPTH, MIX_WIDTH, D_MODEL), MIX_WIDTH ** -0.5),
        'norm2_g': 1.0 + nrm(ks[14], (DEPTH, D_MODEL), 0.02),
        'w_up': nrm(ks[15], (DEPTH, D_MODEL, D_FF), D_MODEL ** -0.5),
        'w_down': nrm(ks[16], (DEPTH, D_FF, D_MODEL), D_FF ** -0.5),
        'final_g': 1.0 + nrm(ks[17], (D_MODEL,), 0.02),
    }


def reference(x_prompt, x_sample, state_hgrn, state_conv, meta_tokens, hg_lb, norm1_g, w_in, hg_onorm_g,
              conv_w, conv_b, conv_ln_g, conv_ln_b, w_out, norm2_g, w_up, w_down, final_g):
    bp = x_prompt.shape[0]
    meta = jnp.broadcast_to(meta_tokens[None].astype(x_prompt.dtype), (bp, N_META, D_MODEL))
    hp = jnp.concatenate([meta, x_prompt], axis=1)
    hs = x_sample
    sp_list, cp_list, ss_list, cs_list = [], [], [], []
    for l in range(DEPTH):
        lb = _layer_lower_bound(hg_lb, l)
        w = (norm1_g[l], w_in[l], hg_onorm_g[l], conv_w[l], conv_b[l], conv_ln_g[l], conv_ln_b[l],
             w_out[l], norm2_g[l], w_up[l], w_down[l])
        s0_p = jnp.zeros((bp, HG_HEADS, HG_DK, HG_DV), jnp.float32)
        buf_p = jnp.zeros((bp, CONV_K - 1, CV_WIDTH), x_prompt.dtype)
        hp, s_p, c_p = _layer(hp, s0_p, buf_p, True, lb, *w)
        hs, s_s, c_s = _layer(hs, state_hgrn[l], state_conv[l], False, lb, *w)
        sp_list.append(s_p)
        cp_list.append(c_p)
        ss_list.append(s_s)
        cs_list.append(c_s)
    y_prompt = _rmsnorm(hp[:, N_META:], final_g)
    y_sample = _rmsnorm(hs, final_g)
    new_state_hgrn_prompt = jnp.stack(sp_list).astype(state_hgrn.dtype)
    new_state_conv_prompt = jnp.stack(cp_list).astype(state_conv.dtype)
    new_state_hgrn_sample = jnp.stack(ss_list).astype(state_hgrn.dtype)
    new_state_conv_sample = jnp.stack(cs_list).astype(state_conv.dtype)
    return (y_prompt, y_sample, new_state_hgrn_prompt, new_state_conv_prompt, new_state_hgrn_sample, new_state_conv_sample)
```

```cpp
#include <hip/hip_runtime.h>
#include <hip/hip_cooperative_groups.h>
#include <cstdio>
#include <cstdint>
namespace cg = cooperative_groups;
namespace pg8 {
#define PG8_LAS __attribute__((address_space(3)))
typedef unsigned short bf16_t;
typedef short bf16x8 __attribute__((ext_vector_type(8)));
typedef float f32x4 __attribute__((ext_vector_type(4)));
typedef unsigned u32x4 __attribute__((ext_vector_type(4)));
constexpr int BM = 256, BK = 64, HALF = 128, HTB = HALF * BK * 2  , STAGE_BYTES = 8 * HTB, NXCD = 8, WGM = 8;

__host__ __device__ __forceinline__ int lds_byte(int r, int c) { const int st = (r >> 4) * 2 + (c >> 5), rr = r & 15, cc = c & 31, ob = rr * 64 + cc * 2; return st * 1024 + (ob ^ (((ob >> 9) & 1) << 5)); }
__host__ __device__ __forceinline__ void stage_rc(int b, int& R, int& C) { const int st = b / 1024, sb = b % 1024, swz = sb ^ (((sb >> 9) & 1) << 5); R = (st >> 1) * 16 + swz / 64; C = (st & 1) * 32 + (swz % 64) / 2; }
__host__ __device__ __forceinline__ int perm32(int rho) { const int n = rho >> 4, i = rho & 15; return 8 * (i >> 2) + 4 * n + (i & 3); }

struct Unit { int pm, pn; };
struct Gemm { const bf16_t* A; const bf16_t* Bt; int M, N, K; };

struct StaticOrder {
    int nM, nN, nwg, G, c;
    __host__ __device__ void init(int M, int N, int G_, int c_) { nM = M / BM; nN = N / BM; nwg = nM * nN; G = G_; c = c_; }
    __host__ __device__ bool next(int i, Unit& u) const {
        const long L = (long)i * G + c; if (L >= nwg) return false;
        int wgid = (int)L; { const int q = nwg / NXCD, r = nwg % NXCD, xcd = wgid % NXCD, off = wgid / NXCD; wgid = (xcd < r ? xcd * (q + 1) : r * (q + 1) + (xcd - r) * q) + off; }
        const int nig = WGM * nN, gid = wgid / nig, fm = gid * WGM, gsz = (nM - fm) < WGM ? (nM - fm) : WGM;
        u.pm = fm + ((wgid % nig) % gsz); u.pn = (wgid % nig) / gsz; return true;
    }
    __device__ __forceinline__ void a_ready(const Unit&) const {}
    __device__ __forceinline__ void done(const Unit&) const {}
};

__device__ __forceinline__ unsigned cvt_pk_bf16(float lo, float hi) { unsigned r; asm volatile("v_cvt_pk_bf16_f32 %0, %1, %2" : "=v"(r) : "v"(lo), "v"(hi)); return r; }
typedef float f32x2 __attribute__((ext_vector_type(2)));
constexpr int ROWS_REAL = 16384, ROW_META = 16384, ROW_SAMP = 16400, ROWS_USED = 16528, MROWS = 16640;
__device__ __forceinline__ float sigm(float x) { return __builtin_amdgcn_rcpf(1.0f + __expf(-x)); }
__device__ __forceinline__ float silu_f(float x) { return x * sigm(x); }
__device__ __forceinline__ u32x4 pack8(const f32x4 a, const f32x4 b) { u32x4 w; w.x = cvt_pk_bf16(a[0], a[1]); w.y = cvt_pk_bf16(a[2], a[3]); w.z = cvt_pk_bf16(b[0], b[1]); w.w = cvt_pk_bf16(b[2], b[3]); return w; }

struct EpiIn {
    static constexpr bool PERM = true, AFTER_DRAIN = false;
    bf16_t *Q, *V, *G, *GLU; float* LF; const float* rs1; const float* LB;
    __device__ __forceinline__ void operator()(const f32x4 (&acc)[2][2][4][2], const Unit& u, int wr, int wc, int fr, int fq) const {
        const int row0 = u.pm * BM + wr * 64 + fr; const int pn = u.pn;
        if (pn < 8) {
            const int type = pn >> 1; const int colb = (pn & 1) * 256 + wc * 32 + 8 * fq;
            f32x4 lb[2][2];
            if (type == 1) {
#pragma unroll
                for (int bj = 0; bj < 2; ++bj)
#pragma unroll
                    for (int n = 0; n < 2; ++n) lb[bj][n] = *(const f32x4*)(LB + colb + bj * HALF + 4 * n);
            }
#pragma unroll
            for (int ai = 0; ai < 2; ++ai)
#pragma unroll
                for (int m = 0; m < 4; ++m) { const int row = row0 + ai * HALF + m * 16; const float rs = rs1[row];
#pragma unroll
                    for (int bj = 0; bj < 2; ++bj) { f32x4 v0 = acc[ai][bj][m][0] * rs, v1 = acc[ai][bj][m][1] * rs; const size_t off = (size_t)row * 512 + colb + bj * HALF;
                        if (type == 1) {
#pragma unroll
                            for (int i = 0; i < 4; ++i) { const float l0 = lb[bj][0][i], l1 = lb[bj][1][i];
                                v0[i] = __logf(l0 + (1.0f - l0) * sigm(v0[i])); v1[i] = __logf(l1 + (1.0f - l1) * sigm(v1[i])); }
                            *(f32x4*)(LF + off) = v0; *(f32x4*)(LF + off + 4) = v1;
                        } else {
                            if (type != 2) {
#pragma unroll
                                for (int i = 0; i < 4; ++i) { v0[i] = silu_f(v0[i]); v1[i] = silu_f(v1[i]); } }
                            const int sel = (type == 0) ? 0 : (type == 2 ? 1 : 3);
                            bf16_t* dst = Q + (size_t)sel * ((size_t)MROWS * 512);
                            *(u32x4*)(dst + off) = pack8(v0, v1);
                        } } }
        } else {
            const int colb = (pn - 8) * 128 + wc * 32 + 8 * fq;
#pragma unroll
            for (int ai = 0; ai < 2; ++ai)
#pragma unroll
                for (int m = 0; m < 4; ++m) { const int row = row0 + ai * HALF + m * 16; const float rs = rs1[row];
                    f32x4 g0, g1;
#pragma unroll
                    for (int i = 0; i < 4; ++i) { g0[i] = acc[ai][0][m][0][i] * rs * sigm(acc[ai][1][m][0][i] * rs); g1[i] = acc[ai][0][m][1][i] * rs * sigm(acc[ai][1][m][1][i] * rs); }
                    *(u32x4*)(GLU + (size_t)row * 512 + colb) = pack8(g0, g1); }
        }
    }
};
__device__ __forceinline__ const float* resid_row(const float* xp, const float* meta, const float* xs, int row) {
    return row < ROWS_REAL ? xp + (size_t)row * 1024 : (row < ROW_SAMP ? meta + (size_t)(row - ROW_META) * 1024 : (row < ROWS_USED ? xs + (size_t)(row - ROW_SAMP) * 1024 : nullptr));
}
struct EpiOut {
    static constexpr bool PERM = true, AFTER_DRAIN = false;
    const float *xp, *meta, *xs; float* H1; bf16_t* HB; float* SS;
    __device__ __forceinline__ void operator()(const f32x4 (&acc)[2][2][4][2], const Unit& u, int wr, int wc, int fr, int fq) const {
        const int row0 = u.pm * BM + wr * 64 + fr; const int colb = u.pn * BM + wc * 32 + 8 * fq;
#pragma unroll
        for (int ai = 0; ai < 2; ++ai)
#pragma unroll
            for (int m = 0; m < 4; ++m) { const int row = row0 + ai * HALF + m * 16; const float* rp = resid_row(xp, meta, xs, row); float ss = 0.f;
#pragma unroll
                for (int bj = 0; bj < 2; ++bj) { const int col = colb + bj * HALF; f32x4 v0 = acc[ai][bj][m][0], v1 = acc[ai][bj][m][1];
                    if (rp) { v0 += *(const f32x4*)(rp + col); v1 += *(const f32x4*)(rp + col + 4); }
                    ss += (v0[0] * v0[0] + v0[1] * v0[1]) + (v0[2] * v0[2] + v0[3] * v0[3]) + (v1[0] * v1[0] + v1[1] * v1[1]) + (v1[2] * v1[2] + v1[3] * v1[3]);
                    const size_t off = (size_t)row * 1024 + col;
                    *(f32x4*)(H1 + off) = v0; *(f32x4*)(H1 + off + 4) = v1; *(u32x4*)(HB + off) = pack8(v0, v1); }
                ss += __shfl_xor(ss, 16); ss += __shfl_xor(ss, 32);
                if (fq == 0) atomicAdd(SS + row, ss); }
    }
};
struct EpiUp {
    static constexpr bool PERM = true, AFTER_DRAIN = false;
    bf16_t* HID; const float* SS;
    __device__ __forceinline__ void operator()(const f32x4 (&acc)[2][2][4][2], const Unit& u, int wr, int wc, int fr, int fq) const {
        const int row0 = u.pm * BM + wr * 64 + fr; const int colb = u.pn * BM + wc * 32 + 8 * fq;
#pragma unroll
        for (int ai = 0; ai < 2; ++ai)
#pragma unroll
            for (int m = 0; m < 4; ++m) { const int row = row0 + ai * HALF + m * 16; const float rs = __builtin_amdgcn_rsqf(SS[row] * (1.0f / 1024.0f) + 1e-6f);
#pragma unroll
                for (int bj = 0; bj < 2; ++bj) { f32x4 v0 = acc[ai][bj][m][0] * rs, v1 = acc[ai][bj][m][1] * rs;
#pragma unroll
                    for (int i = 0; i < 4; ++i) { const float a = fmaxf(v0[i], 0.f), b = fmaxf(v1[i], 0.f); v0[i] = a * a; v1[i] = b * b; }
                    *(u32x4*)(HID + (size_t)row * 4096 + colb + bj * HALF) = pack8(v0, v1); } }
    }
};
struct EpiDown {
    static constexpr bool PERM = true, AFTER_DRAIN = false;
    const float* H1; float* yp; float* ys; float* SS;
    __device__ __forceinline__ void operator()(const f32x4 (&acc)[2][2][4][2], const Unit& u, int wr, int wc, int fr, int fq) const {
        const int row0 = u.pm * BM + wr * 64 + fr; const int colb = u.pn * BM + wc * 32 + 8 * fq;
#pragma unroll
        for (int ai = 0; ai < 2; ++ai)
#pragma unroll
            for (int m = 0; m < 4; ++m) { const int row = row0 + ai * HALF + m * 16;
                float* op = row < ROWS_REAL ? yp + (size_t)row * 1024 : ((row >= ROW_SAMP && row < ROWS_USED) ? ys + (size_t)(row - ROW_SAMP) * 1024 : nullptr);
                if (op) { float ss = 0.f;
#pragma unroll
                    for (int bj = 0; bj < 2; ++bj) { const int col = colb + bj * HALF; const size_t off = (size_t)row * 1024 + col;
                        const f32x4 v0 = acc[ai][bj][m][0] + *(const f32x4*)(H1 + off), v1 = acc[ai][bj][m][1] + *(const f32x4*)(H1 + off + 4);
                        ss += (v0[0] * v0[0] + v0[1] * v0[1]) + (v0[2] * v0[2] + v0[3] * v0[3]) + (v1[0] * v1[0] + v1[1] * v1[1]) + (v1[2] * v1[2] + v1[3] * v1[3]);
                        *(f32x4*)(op + col) = v0; *(f32x4*)(op + col + 4) = v1; }
                    ss += __shfl_xor(ss, 16); ss += __shfl_xor(ss, 32);
                    if (fq == 0) atomicAdd(SS + row, ss); } }
    }
};
template <class Epi, class Sched, bool ALIGN_EPI = false, bool SP2 = false>
__device__ __forceinline__ void gemm_phase(PG8_LAS unsigned char* lds, const Gemm g, const Sched& S, const Epi& E) {
    const int tid = threadIdx.x, wid = __builtin_amdgcn_readfirstlane(tid >> 6), lane = tid & 63, wr = wid >> 2, wc = wid & 3, fr = lane & 15, fq = lane >> 4;
    const int K = g.K, nt = K / BK;
    unsigned voffA[2], voffB[2];
#pragma unroll
    for (int i = 0; i < 2; ++i) { int R, C; stage_rc(tid * 16 + i * 8192, R, C); const int Rb = Epi::PERM ? ((R & ~31) + perm32(R & 31)) : R;
        voffA[i] = (unsigned)(R * K + C) * 2u; voffB[i] = (unsigned)(Rb * K + C) * 2u; }
    const size_t kstep = (size_t)(BK * 2);
    const size_t hstep = (size_t)HALF * K * 2;
    const size_t tstep = 2 * hstep;
    const unsigned ldsw = (unsigned)wid * 1024u;
    const int aoff = lds_byte(wr * 64 + fr, fq * 8), boff = lds_byte(wc * 32 + fr, fq * 8);
#define PG8_SA(b, h) (((b) * 2 + (h)) * HTB)
#define PG8_SB(b, h) ((4 + (b) * 2 + (h)) * HTB)
#define PG8_STAGE(bufoff, gbase, voff) do { _Pragma("unroll") for (int _i = 0; _i < 2; ++_i) \
        __builtin_amdgcn_global_load_lds((const unsigned*)((const char*)(gbase) + (voff)[_i]), (PG8_LAS unsigned*)(lds + (bufoff) + ldsw + _i * 8192), 16, 0, 0); } while (0)
#define PG8_LDA(dst, b, h) do { _Pragma("unroll") for (int m = 0; m < 4; ++m) _Pragma("unroll") for (int k = 0; k < 2; ++k) dst[m][k] = *(const PG8_LAS bf16x8*)(lds + PG8_SA(b, h) + aoff + m * 2048 + k * 1024); } while (0)
#define PG8_LDB(dst, b, h) do { _Pragma("unroll") for (int n = 0; n < 2; ++n) _Pragma("unroll") for (int k = 0; k < 2; ++k) dst[n][k] = *(const PG8_LAS bf16x8*)(lds + PG8_SB(b, h) + boff + n * 2048 + k * 1024); } while (0)
#define PG8_MMA(ai, bj, At, Bt) do { __builtin_amdgcn_s_setprio(1); _Pragma("unroll") for (int m = 0; m < 4; ++m) _Pragma("unroll") for (int n = 0; n < 2; ++n) _Pragma("unroll") for (int k = 0; k < 2; ++k) \
        acc[ai][bj][m][n] = __builtin_amdgcn_mfma_f32_16x16x32_bf16(Bt[n][k], At[m][k], acc[ai][bj][m][n], 0, 0, 0); __builtin_amdgcn_s_setprio(0); } while (0)
#define PG8_WAIT_V(n) asm volatile("s_waitcnt vmcnt(" #n ")" ::: "memory")
#define PG8_WAIT_L(n) asm volatile("s_waitcnt lgkmcnt(" #n ")" ::: "memory")
#define PG8_BAR __builtin_amdgcn_s_barrier()
#define PG8_SCHED __builtin_amdgcn_sched_barrier(0)
    Unit cur, nxt; int ui = 0;
    if (!S.next(0, cur)) return;
    f32x4 acc[2][2][4][2];
#pragma unroll
    for (int a = 0; a < 2; ++a)
#pragma unroll
        for (int b = 0; b < 2; ++b)
#pragma unroll
            for (int m = 0; m < 4; ++m)
#pragma unroll
                for (int n = 0; n < 2; ++n) acc[a][b][m][n] = (f32x4){0.f, 0.f, 0.f, 0.f};
    bf16x8 At[4][2], B0[2][2], B1[2][2];
    const char* cA = (const char*)g.A + (size_t)cur.pm * tstep; const char* cB = (const char*)g.Bt + (size_t)cur.pn * tstep;
    S.a_ready(cur);
    if constexpr (SP2) {
        PG8_STAGE(PG8_SB(0, 0), cB, voffB); PG8_STAGE(PG8_SB(0, 1), cB + hstep, voffB); PG8_STAGE(PG8_SA(0, 0), cA, voffA); PG8_STAGE(PG8_SA(0, 1), cA + hstep, voffA);
        if (wr == 1) PG8_BAR;
        PG8_WAIT_V(2); PG8_BAR;
        PG8_STAGE(PG8_SB(1, 0), cB + kstep, voffB); PG8_STAGE(PG8_SA(1, 0), cA + kstep, voffA); PG8_STAGE(PG8_SB(1, 1), cB + hstep + kstep, voffB);
        PG8_WAIT_V(6); PG8_BAR;
    } else {
        PG8_STAGE(PG8_SB(0, 0), cB, voffB); PG8_STAGE(PG8_SA(0, 0), cA, voffA); PG8_STAGE(PG8_SB(0, 1), cB + hstep, voffB); PG8_STAGE(PG8_SA(0, 1), cA + hstep, voffA);
        if (wr == 1) PG8_BAR;
        PG8_WAIT_V(4); PG8_BAR;
        PG8_STAGE(PG8_SB(1, 0), cB + kstep, voffB); PG8_STAGE(PG8_SA(1, 0), cA + kstep, voffA); PG8_STAGE(PG8_SB(1, 1), cB + hstep + kstep, voffB);
        PG8_WAIT_V(6); PG8_BAR;
    }
    for (;;) {
        const bool has_next = S.next(ui + 1, nxt);
        const char* nA = has_next ? (const char*)g.A + (size_t)nxt.pm * tstep : cA; const char* nB = has_next ? (const char*)g.Bt + (size_t)nxt.pn * tstep : cB;
        for (int t = 0; t < nt; t += 2) {
            const bool last = (t == nt - 2);
            const char* a1 = cA + (size_t)(t + 1) * kstep;
            const char* a2 = last ? nA : cA + (size_t)(t + 2) * kstep; const char* b2 = last ? nB : cB + (size_t)(t + 2) * kstep;
            const char* a3 = a2 + kstep; const char* b3 = b2 + kstep;
            if (last && has_next) S.a_ready(nxt);
            if constexpr (SP2) {
            PG8_LDB(B0, 0, 0); PG8_LDB(B1, 0, 1); PG8_SCHED; PG8_LDA(At, 0, 0); PG8_STAGE(PG8_SA(1, 1), a1 + hstep, voffA);
            PG8_WAIT_V(8); PG8_WAIT_L(0); PG8_BAR; PG8_MMA(0, 0, At, B0); PG8_MMA(0, 1, At, B1); PG8_BAR; PG8_SCHED;
            PG8_LDA(At, 0, 1); PG8_STAGE(PG8_SB(0, 0), b2, voffB); PG8_STAGE(PG8_SB(0, 1), b2 + hstep, voffB); PG8_STAGE(PG8_SA(0, 0), a2, voffA);
            PG8_WAIT_V(8); PG8_WAIT_L(0); PG8_BAR; PG8_MMA(1, 0, At, B0); PG8_MMA(1, 1, At, B1); PG8_BAR; PG8_SCHED;
            PG8_LDB(B0, 1, 0); PG8_LDB(B1, 1, 1); PG8_SCHED; PG8_LDA(At, 1, 0); PG8_STAGE(PG8_SA(0, 1), a2 + hstep, voffA);
            PG8_WAIT_V(8); PG8_WAIT_L(0); PG8_BAR; PG8_MMA(0, 0, At, B0); PG8_MMA(0, 1, At, B1); PG8_BAR; PG8_SCHED;
            PG8_LDA(At, 1, 1); PG8_STAGE(PG8_SB(1, 0), b3, voffB); PG8_STAGE(PG8_SB(1, 1), b3 + hstep, voffB); PG8_STAGE(PG8_SA(1, 0), a3, voffA);
            PG8_WAIT_V(8); PG8_WAIT_L(0); PG8_BAR; PG8_MMA(1, 0, At, B0); PG8_MMA(1, 1, At, B1); PG8_BAR; PG8_SCHED;
            } else {
            PG8_LDB(B0, 0, 0); PG8_SCHED; PG8_LDA(At, 0, 0); PG8_STAGE(PG8_SA(1, 1), a1 + hstep, voffA);
            PG8_WAIT_L(8); PG8_BAR; PG8_WAIT_L(0); PG8_MMA(0, 0, At, B0); PG8_BAR; PG8_SCHED;
            PG8_LDB(B1, 0, 1); PG8_STAGE(PG8_SB(0, 0), b2, voffB);
            PG8_BAR; PG8_WAIT_L(0); PG8_MMA(0, 1, At, B1); PG8_BAR;
            PG8_LDA(At, 0, 1); PG8_STAGE(PG8_SA(0, 0), a2, voffA);
            PG8_BAR; PG8_WAIT_L(0); PG8_MMA(1, 0, At, B0); PG8_BAR; PG8_SCHED;
            PG8_STAGE(PG8_SB(0, 1), b2 + hstep, voffB);
            PG8_WAIT_V(6); PG8_BAR; PG8_MMA(1, 1, At, B1); PG8_BAR;
            PG8_LDB(B0, 1, 0); PG8_SCHED; PG8_LDA(At, 1, 0); PG8_STAGE(PG8_SA(0, 1), a2 + hstep, voffA);
            PG8_WAIT_L(8); PG8_BAR; PG8_WAIT_L(0); PG8_MMA(0, 0, At, B0); PG8_BAR; PG8_SCHED;
            PG8_LDB(B1, 1, 1); PG8_STAGE(PG8_SB(1, 0), b3, voffB);
            PG8_BAR; PG8_WAIT_L(0); PG8_MMA(0, 1, At, B1); PG8_BAR;
            PG8_LDA(At, 1, 1); PG8_STAGE(PG8_SA(1, 0), a3, voffA);
            PG8_BAR; PG8_WAIT_L(0); PG8_MMA(1, 0, At, B0); PG8_BAR; PG8_SCHED;
            PG8_STAGE(PG8_SB(1, 1), b3 + hstep, voffB);
            PG8_WAIT_V(6); PG8_BAR; PG8_MMA(1, 1, At, B1); PG8_BAR;
            }
        }
        if constexpr (ALIGN_EPI) { if (wr == 0) PG8_BAR; }
        if constexpr (!Epi::AFTER_DRAIN) { E(acc, cur, wr, wc, fr, fq); S.done(cur); }
        if (!has_next) break;
#pragma unroll
        for (int a = 0; a < 2; ++a)
#pragma unroll
            for (int b = 0; b < 2; ++b)
#pragma unroll
                for (int m = 0; m < 4; ++m)
#pragma unroll
                    for (int n = 0; n < 2; ++n) acc[a][b][m][n] = (f32x4){0.f, 0.f, 0.f, 0.f};
        cur = nxt; cA = nA; cB = nB; ++ui;
        if constexpr (ALIGN_EPI) { if (wr == 1) PG8_BAR; }
    }
    PG8_WAIT_V(0);
    if constexpr (!ALIGN_EPI) { if (wr == 0) PG8_BAR; }
    PG8_BAR;
    if constexpr (Epi::AFTER_DRAIN) { E.fused(acc, cur, wr, wc, fr, fq, lds, wid, lane); S.done(cur); }
#undef PG8_SA
#undef PG8_SB
#undef PG8_STAGE
#undef PG8_LDA
#undef PG8_LDB
#undef PG8_MMA
#undef PG8_WAIT_V
#undef PG8_WAIT_L
#undef PG8_BAR
#undef PG8_SCHED
}
}

#define LAS __attribute__((address_space(3)))
typedef unsigned short bf16;
typedef unsigned v4u __attribute__((ext_vector_type(4)));
typedef unsigned v2u __attribute__((ext_vector_type(2)));
typedef float f32x4 __attribute__((ext_vector_type(4)));
typedef short bf16x8 __attribute__((ext_vector_type(8)));
constexpr int NWAVES = 8, NTHR = 512;
constexpr int D = 1024, NIN = 3072, FF = 4096, HW = 512;
constexpr int ROWS_REAL = pg8::ROWS_REAL, ROW_META = pg8::ROW_META, ROW_SAMP = pg8::ROW_SAMP, ROWS_USED = pg8::ROWS_USED, MROWS = pg8::MROWS;
constexpr int NB = 8, SEQ = 2048, NCH = 32, NSAMP = 128;
constexpr float EPS = 1e-6f;
constexpr int LDS_BYTES = 147456;

constexpr size_t KiB = 1024, MiB = 1u << 20;
constexpr size_t OFF_SS2 = 0, OFF_SS3 = 128 * KiB, OFF_RS1 = 256 * KiB, OFF_LB = 384 * KiB, OFF_DSM = 512 * KiB;
constexpr size_t WS_WIN = 1 * MiB, WS_WOUT = 7 * MiB, WS_WUP = 9 * MiB, WS_WDN = 17 * MiB;
constexpr size_t WS_XB = 25 * MiB;
constexpr size_t WS_DS = 25 * MiB;
constexpr size_t WS_DEC = 89 * MiB;
constexpr size_t WS_LF = 89 * MiB + 512 * KiB;
constexpr size_t WS_SST = WS_LF;
constexpr size_t SZH = (size_t)MROWS * 512 * 2;
constexpr size_t WS_Q = 122 * MiB, WS_V = WS_Q + SZH, WS_GLU = WS_V + SZH, WS_G = WS_GLU + SZH, WS_QD = WS_G + SZH, WS_OI = WS_QD + SZH, WS_YM = WS_OI + SZH;
constexpr size_t WS_H1 = 25 * MiB;
constexpr size_t WS_HB = 90 * MiB;
constexpr size_t WS_HID = 122 * MiB + 512 * KiB;
constexpr size_t WS_END = 253 * MiB;
static_assert(WS_YM + 2 * SZH <= 252 * MiB + 1 && WS_HID + (size_t)MROWS * FF * 2 <= WS_END && WS_LF + (size_t)MROWS * 512 * 4 <= WS_Q, "ws map");

struct Args {
    const float *x_prompt, *x_sample, *state_hgrn, *state_conv, *meta, *hg_lb, *norm1_g, *w_in, *hg_onorm_g, *conv_w, *conv_b, *conv_ln_g, *conv_ln_b, *w_out, *norm2_g, *w_up, *w_down, *final_g;
    float* out; unsigned char* ws; int ph_lo, ph_hi, coop, pad;
};
constexpr size_t O_YP = 0, O_YS = (size_t)ROWS_REAL * D, O_SHP = O_YS + (size_t)NSAMP * D, O_SCP = O_SHP + (size_t)NB * 4 * 128 * 128, O_SHS = O_SCP + (size_t)NB * 30 * 512, O_SCS = O_SHS + (size_t)NSAMP * 4 * 128 * 128;

__device__ __forceinline__ unsigned f2bf(float f) { unsigned u = __builtin_bit_cast(unsigned, f); return (u + 0x7fffu + ((u >> 16) & 1u)) >> 16; }
__device__ __forceinline__ unsigned pk2(float lo, float hi) { return f2bf(lo) | (f2bf(hi) << 16); }
__device__ __forceinline__ float bf2f(unsigned short b) { return __builtin_bit_cast(float, (unsigned)b << 16); }
__device__ __forceinline__ float bflo(unsigned w) { return __builtin_bit_cast(float, w << 16); }
__device__ __forceinline__ float bfhi(unsigned w) { return __builtin_bit_cast(float, w & 0xffff0000u); }
__device__ __forceinline__ float wave_sum(float v) {
#pragma unroll
    for (int o = 1; o < 64; o <<= 1) v += __shfl_xor(v, o);
    return v;
}
#define LDS_WAIT() asm volatile("s_waitcnt lgkmcnt(0)" ::: "memory")

template <bool IN_PERM>
__device__ __forceinline__ void p0_transpose_item(const float* W, const float* g, int K, int N, bf16* WT, LAS float* scr, int item, int lane) {
    const int nblk = N / 32, kb = item / nblk, nb = item % nblk, k0 = 64 * kb, n0 = 32 * nb;
    int s0 = n0;
    if (IN_PERM && n0 >= 2048) { const int j = (n0 - 2048) >> 8, w = (n0 - 2048) & 255; s0 = (w < 128) ? 2048 + 128 * j + w : 2560 + 128 * j + (w - 128); }
#pragma unroll 8
    for (int i = 0; i < 32; ++i) { const int kk = 2 * i + (lane >> 5); const float gg = g ? g[k0 + kk] : 1.0f; scr[kk * 33 + (lane & 31)] = gg * W[(size_t)(k0 + kk) * N + s0 + (lane & 31)]; }
    LDS_WAIT(); asm volatile("" ::: "memory");
    const int c = lane & 7;
#pragma unroll
    for (int j = 0; j < 4; ++j) { const int n = (lane >> 3) + 8 * j; const LAS float* s = scr + (8 * c) * 33 + n;
        v4u o; o.x = pk2(s[0 * 33], s[1 * 33]); o.y = pk2(s[2 * 33], s[3 * 33]); o.z = pk2(s[4 * 33], s[5 * 33]); o.w = pk2(s[6 * 33], s[7 * 33]);
        *(v4u*)(WT + (size_t)(n0 + n) * K + k0 + 8 * c) = o; }
    LDS_WAIT(); asm volatile("" ::: "memory");
}
__device__ __forceinline__ void p0_prologue(const Args& a, LAS unsigned char* lds, int tid, int lane, int wave) {
    unsigned char* ws = a.ws;
    const int gw = blockIdx.x * NWAVES + wave, NGW = gridDim.x * NWAVES; const int gt = blockIdx.x * NTHR + tid, NGT = gridDim.x * NTHR;
    float* SS2 = (float*)(ws + OFF_SS2); float* SS3 = (float*)(ws + OFF_SS3); float* RS1 = (float*)(ws + OFF_RS1); float* LB = (float*)(ws + OFF_LB);
    for (int i = gt; i < MROWS; i += NGT) { SS2[i] = 0.f; SS3[i] = 0.f; }
    if (gt < 512) { const float p0 = a.hg_lb[gt], p1 = a.hg_lb[512 + gt]; const float m = fmaxf(p0, p1), e0 = __expf(p0 - m), e1 = __expf(p1 - m); LB[gt] = e0 / (e0 + e1); }
    LAS float* scr = (LAS float*)(lds + wave * 16384);
    constexpr int I_IN = (D / 64) * (NIN / 32), I_OUT = (D / 64) * (D / 32), I_UP = (D / 64) * (FF / 32), I_DN = (FF / 64) * (D / 32);
    constexpr int NITEMS = I_IN + I_OUT + I_UP + I_DN;
    for (int it = gw; it < NITEMS; it += NGW) {
        int r = it;
        if (r < I_IN) { p0_transpose_item<true>(a.w_in, a.norm1_g, D, NIN, (bf16*)(ws + WS_WIN), scr, r, lane); continue; } r -= I_IN;
        if (r < I_OUT) { p0_transpose_item<false>(a.w_out, nullptr, D, D, (bf16*)(ws + WS_WOUT), scr, r, lane); continue; } r -= I_OUT;
        if (r < I_UP) { p0_transpose_item<false>(a.w_up, a.norm2_g, D, FF, (bf16*)(ws + WS_WUP), scr, r, lane); continue; } r -= I_UP;
        p0_transpose_item<false>(a.w_down, nullptr, FF, D, (bf16*)(ws + WS_WDN), scr, r, lane);
    }
    bf16* XB = (bf16*)(ws + WS_XB);
    for (int m = gw; m < MROWS; m += NGW) {
        const float* xr = pg8::resid_row(a.x_prompt, a.meta, a.x_sample, m);
        unsigned long long* o8 = (unsigned long long*)(XB + (size_t)m * D) + lane;
        if (xr) { f32x4 v[4]; float s = 0.f;
#pragma unroll
            for (int j = 0; j < 4; ++j) { v[j] = ((const f32x4*)xr)[lane + 64 * j]; s += (v[j].x * v[j].x + v[j].y * v[j].y) + (v[j].z * v[j].z + v[j].w * v[j].w); }
            s = wave_sum(s);
            if (lane == 0) RS1[m] = __builtin_amdgcn_rsqf(s * (1.0f / D) + EPS);
#pragma unroll
            for (int j = 0; j < 4; ++j) o8[64 * j] = (unsigned long long)pk2(v[j].x, v[j].y) | ((unsigned long long)pk2(v[j].z, v[j].w) << 32);
        } else {
            if (lane == 0) RS1[m] = 0.f;
#pragma unroll
            for (int j = 0; j < 4; ++j) o8[64 * j] = 0ull;
        }
    }
}

constexpr int L_QD = 0, L_KI = 17408, L_KIT = 34816, L_VT = 53248, L_SC = 71680, L_PART = 80896, L_DEC = 82944;
__device__ __forceinline__ bf16x8 lds_frag(LAS unsigned char* base, int row, int stride_b, int kbyte) { return *(const LAS bf16x8*)(base + row * stride_b + kbyte); }
__device__ __forceinline__ void hgrn_chunk_item(const Args& a, LAS unsigned char* lds, int item, int tid, int lane, int wave) {
    unsigned char* ws = a.ws;
    const bool meta = item >= 1024; const int h = meta ? item - 1024 : (item & 3), bn = meta ? 0 : (item >> 2);
    const float* LF = (const float*)(ws + WS_LF); const bf16* Q = (const bf16*)(ws + WS_Q); const bf16* V = (const bf16*)(ws + WS_V);
    bf16* QDg = (bf16*)(ws + WS_QD); bf16* OI = (bf16*)(ws + WS_OI); float* DEC = (float*)(ws + WS_DEC);
    float* DSo = meta ? (float*)(ws + OFF_DSM) + (size_t)h * 16384 : (float*)(ws + WS_DS) + ((size_t)bn * 4 + h) * 16384;
    const int d = tid & 127, tq = tid >> 7; const bool valid = !meta || tq == 3;
    const int rbase = meta ? ROW_META : bn * 64 + 16 * tq;
    const size_t cbase = (size_t)rbase * 512 + h * 128 + d;
    LAS float* PART = (LAS float*)(lds + L_PART); LAS float* DECl = (LAS float*)(lds + L_DEC);
    float c[16];
    { float run = 0.f;
#pragma unroll
      for (int i = 0; i < 16; ++i) { const float lf = valid ? LF[cbase + (size_t)i * 512] : 0.f; run += lf; c[i] = run; }
      PART[tq * 128 + d] = run; }
    __syncthreads();
    float off = 0.f, bend = 0.f;
#pragma unroll
    for (int j = 0; j < 4; ++j) { const float pj = PART[j * 128 + d]; bend += pj; if (j < tq) off += pj; }
    unsigned kit[8], vt[8];
    float prev = 0.f;
#pragma unroll
    for (int i = 0; i < 16; ++i) {
        const float bcur = off + c[i], lf = c[i] - prev; prev = c[i];
        const float e = __expf(bcur), einv = __expf(-bcur);
        float q = 0.f, k = 0.f, v = 0.f;
        if (valid) { q = bf2f(Q[cbase + (size_t)i * 512]); v = bf2f(V[cbase + (size_t)i * 512]); k = 1.0f - __expf(lf); }
        const unsigned qd = f2bf(q * e), ki = f2bf(k * einv), vb = f2bf(v);
        const int t = 16 * tq + i;
        *(LAS unsigned short*)(lds + L_QD + t * 272 + d * 2) = (unsigned short)qd;
        *(LAS unsigned short*)(lds + L_KI + t * 272 + d * 2) = (unsigned short)ki;
        if (!meta) QDg[cbase + (size_t)i * 512] = (unsigned short)qd;
        if (i & 1) { kit[i >> 1] |= ki << 16; vt[i >> 1] |= vb << 16; } else { kit[i >> 1] = ki; vt[i >> 1] = vb; }
    }
    { LAS v4u* pk = (LAS v4u*)(lds + L_KIT + d * 144 + tq * 32); pk[0] = (v4u){kit[0], kit[1], kit[2], kit[3]}; pk[1] = (v4u){kit[4], kit[5], kit[6], kit[7]};
      LAS v4u* pv = (LAS v4u*)(lds + L_VT + d * 144 + tq * 32); pv[0] = (v4u){vt[0], vt[1], vt[2], vt[3]}; pv[1] = (v4u){vt[4], vt[5], vt[6], vt[7]}; }
    if (tq == 0) { const float dc = __expf(bend); DECl[d] = dc; if (!meta) DEC[(size_t)bn * 512 + h * 128 + d] = dc; }
    __syncthreads();
    const int fr = lane & 15, fq = lane >> 4;
    if (!meta) {
#pragma unroll
        for (int x = 0; x < 2; ++x) { const int idx = wave * 2 + x, tt = idx >> 2, st = idx & 3;
            f32x4 acc = {0.f, 0.f, 0.f, 0.f};
            if (st <= tt) {
#pragma unroll
                for (int ks = 0; ks < 4; ++ks) { const bf16x8 fa = lds_frag(lds + L_KI, 16 * st + fr, 272, 64 * ks + 16 * fq), fb = lds_frag(lds + L_QD, 16 * tt + fr, 272, 64 * ks + 16 * fq);
                    acc = __builtin_amdgcn_mfma_f32_16x16x32_bf16(fa, fb, acc, 0, 0, 0); }
                const int t = 16 * tt + fr, s0 = 16 * st + 4 * fq;
#pragma unroll
                for (int r = 0; r < 4; ++r) if (s0 + r > t) acc[r] = 0.f;
            }
            *(LAS v2u*)(lds + L_SC + (16 * tt + fr) * 144 + (16 * st + 4 * fq) * 2) = (v2u){pk2(acc[0], acc[1]), pk2(acc[2], acc[3])}; }
    }
    __syncthreads();
    const int vt_i = wave;
    const bf16x8 fv0 = lds_frag(lds + L_VT, 16 * vt_i + fr, 144, 16 * fq), fv1 = lds_frag(lds + L_VT, 16 * vt_i + fr, 144, 64 + 16 * fq);
    if (!meta) {
#pragma unroll
        for (int tt = 0; tt < 4; ++tt) { f32x4 acc = {0.f, 0.f, 0.f, 0.f};
            const bf16x8 s0 = lds_frag(lds + L_SC, 16 * tt + fr, 144, 16 * fq), s1 = lds_frag(lds + L_SC, 16 * tt + fr, 144, 64 + 16 * fq);
            acc = __builtin_amdgcn_mfma_f32_16x16x32_bf16(fv0, s0, acc, 0, 0, 0); acc = __builtin_amdgcn_mfma_f32_16x16x32_bf16(fv1, s1, acc, 0, 0, 0);
            *(v2u*)(OI + (size_t)(bn * 64 + 16 * tt + fr) * 512 + h * 128 + 16 * vt_i + 4 * fq) = (v2u){pk2(acc[0], acc[1]), pk2(acc[2], acc[3])}; }
    }
#pragma unroll
    for (int dt = 0; dt < 8; ++dt) { f32x4 acc = {0.f, 0.f, 0.f, 0.f};
        const bf16x8 k0 = lds_frag(lds + L_KIT, 16 * dt + fr, 144, 16 * fq), k1 = lds_frag(lds + L_KIT, 16 * dt + fr, 144, 64 + 16 * fq);
        acc = __builtin_amdgcn_mfma_f32_16x16x32_bf16(k0, fv0, acc, 0, 0, 0); acc = __builtin_amdgcn_mfma_f32_16x16x32_bf16(k1, fv1, acc, 0, 0, 0);
        const f32x4 dc = *(const LAS f32x4*)(DECl + 16 * dt + 4 * fq);
        *(f32x4*)(DSo + (size_t)(16 * vt_i + fr) * 128 + 16 * dt + 4 * fq) = acc * dc; }
    __syncthreads();
}

__device__ __forceinline__ void conv_item(const Args& a, LAS unsigned char* lds, int item, int tid, int lane, int wave) {
    unsigned char* ws = a.ws; const bf16* GLU = (const bf16*)(ws + WS_GLU); bf16* YM = (bf16*)(ws + WS_YM);
    const int b = item >> 5, g = item & 31, c = tid; const int r0 = b * SEQ + g * 64;
    float w[31];
#pragma unroll
    for (int j = 0; j < 31; ++j) w[j] = a.conv_w[j * 512 + c];
    const float bias = a.conv_b[c];
    LAS float* DW = (LAS float*)lds;
    LAS unsigned short* GW = (LAS unsigned short*)(lds + 65536);
    float lg[8], lb[8];
#pragma unroll
    for (int i = 0; i < 8; ++i) { lg[i] = a.conv_ln_g[8 * lane + i]; lb[i] = a.conv_ln_b[8 * lane + i]; }
    for (int grp = 0; grp < 2; ++grp) {
        const int rg = r0 + 32 * grp;
#pragma unroll
        for (int k = 0; k < 8; ++k) { const int q = tid + 512 * k; const int rr = q >> 6, cc = (q & 63) * 8;
            if (rr < 62) { const int tp = g * 64 + 32 * grp + rr - 30; v4u x = {0u, 0u, 0u, 0u};
                if (tp >= 0) x = *(const v4u*)(GLU + (size_t)(b * SEQ + tp) * 512 + cc); else if (tp >= -16) x = *(const v4u*)(GLU + (size_t)(ROW_META + 16 + tp) * 512 + cc);
                *(LAS v4u*)(GW + rr * 512 + cc) = x; } }
        __syncthreads();
        if (g == 31 && grp == 1) {
#pragma unroll 1
            for (int i = 2; i < 32; ++i) a.out[O_SCP + (size_t)(b * 30 + i - 2) * 512 + c] = bf2f(GW[(30 + i) * 512 + c]); }
#pragma unroll 1
        for (int ib = 0; ib < 4; ++ib) {
            const LAS unsigned short* gp = GW + ib * 8 * 512 + c; LAS float* dp = DW + ib * 8 * 512 + c;
            float xv[38];
#pragma unroll
            for (int i = 0; i < 38; ++i) xv[i] = bf2f(gp[i * 512]);
#pragma unroll
            for (int i = 0; i < 8; ++i) {
                float acc = bias;
#pragma unroll
                for (int j = 0; j < 31; ++j) acc += w[j] * xv[i + j];
                dp[i * 512] = acc;
            }
        }
        __syncthreads();
#pragma unroll
        for (int rr = 0; rr < 4; ++rr) { const int i = wave + 8 * rr;
            const f32x4 x0 = *(const LAS f32x4*)(DW + i * 512 + 8 * lane), x1 = *(const LAS f32x4*)(DW + i * 512 + 8 * lane + 4);
            const float mean = wave_sum((x0[0] + x0[1]) + (x0[2] + x0[3]) + (x1[0] + x1[1]) + (x1[2] + x1[3])) * (1.0f / 512.0f);
            const f32x4 d0 = x0 - mean, d1 = x1 - mean;
            const float var = wave_sum((d0[0] * d0[0] + d0[1] * d0[1]) + (d0[2] * d0[2] + d0[3] * d0[3]) + (d1[0] * d1[0] + d1[1] * d1[1]) + (d1[2] * d1[2] + d1[3] * d1[3])) * (1.0f / 512.0f);
            const float rstd = __builtin_amdgcn_rsqf(var + EPS);
            float y[8];
#pragma unroll
            for (int k = 0; k < 4; ++k) { y[k] = pg8::silu_f(d0[k] * rstd * lg[k] + lb[k]); y[4 + k] = pg8::silu_f(d1[k] * rstd * lg[4 + k] + lb[4 + k]); }
            *(v4u*)(YM + (size_t)(rg + i) * 1024 + 512 + 8 * lane) = (v4u){pk2(y[0], y[1]), pk2(y[2], y[3]), pk2(y[4], y[5]), pk2(y[6], y[7])}; }
        __syncthreads();
    }
}

__device__ __forceinline__ void sample_item(const Args& a, LAS unsigned char* lds, int s, int tid, int lane, int wave) {
    unsigned char* ws = a.ws; const int row = ROW_SAMP + s;
    const bf16* GLU = (const bf16*)(ws + WS_GLU); bf16* YM = (bf16*)(ws + WS_YM);
    const float* LF = (const float*)(ws + WS_LF); const bf16* Q = (const bf16*)(ws + WS_Q); const bf16* V = (const bf16*)(ws + WS_V); const bf16* G = (const bf16*)(ws + WS_G);
    LAS float* RED = (LAS float*)lds;
    LAS float* OP = (LAS float*)(lds + 1024);
    {
        const int c = tid; const float* sc = a.state_conv + (size_t)s * 30 * 512 + c; float* so = a.out + O_SCS + (size_t)s * 30 * 512 + c;
        const float glu = bf2f(GLU[(size_t)row * 512 + c]);
        float acc = a.conv_b[c];
#pragma unroll
        for (int j = 0; j < 30; ++j) { const float x = sc[j * 512]; acc += a.conv_w[j * 512 + c] * x; if (j >= 1) so[(j - 1) * 512] = x; }
        acc += a.conv_w[30 * 512 + c] * glu; so[29 * 512] = glu;
        float sm = wave_sum(acc); if (lane == 0) RED[wave] = sm;
        __syncthreads();
        float mean = 0.f;
#pragma unroll
        for (int j = 0; j < 8; ++j) mean += RED[j];
        mean *= (1.0f / 512.0f);
        const float dd = acc - mean; float sv = wave_sum(dd * dd); if (lane == 0) RED[8 + wave] = sv;
        __syncthreads();
        float var = 0.f;
#pragma unroll
        for (int j = 0; j < 8; ++j) var += RED[8 + j];
        const float rstd = __builtin_amdgcn_rsqf(var * (1.0f / 512.0f) + EPS);
        const float y = pg8::silu_f(dd * rstd * a.conv_ln_g[c] + a.conv_ln_b[c]);
        YM[(size_t)row * 1024 + 512 + c] = (unsigned short)f2bf(y);
    }
    const int vq = tid & 31, dg = tid >> 5;
    for (int h = 0; h < 4; ++h) {
        const size_t hb = (size_t)row * 512 + h * 128;
        const v2u vv = *(const v2u*)(V + hb + 4 * vq); const f32x4 v4 = {bflo(vv.x), bfhi(vv.x), bflo(vv.y), bfhi(vv.y)};
        const float* Sin = a.state_hgrn + ((size_t)(s * 4 + h) * 128) * 128 + 4 * vq; float* Sout = a.out + O_SHS + ((size_t)(s * 4 + h) * 128) * 128 + 4 * vq;
        f32x4 o4 = {0.f, 0.f, 0.f, 0.f};
#pragma unroll
        for (int dd = 0; dd < 8; ++dd) { const int d = 8 * dg + dd; const float f = __expf(LF[hb + d]), k = 1.0f - f, q = bf2f(Q[hb + d]);
            f32x4 S = *(const f32x4*)(Sin + (size_t)d * 128); S = S * f + v4 * k; *(f32x4*)(Sout + (size_t)d * 128) = S; o4 += S * q; }
        __syncthreads();
        *(LAS f32x4*)(OP + dg * 128 + 4 * vq) = o4;
        __syncthreads();
        if (wave == 0) { float oa = 0.f, ob = 0.f;
#pragma unroll
            for (int j = 0; j < 16; ++j) { oa += OP[j * 128 + lane]; ob += OP[j * 128 + 64 + lane]; }
            const float rstd = __builtin_amdgcn_rsqf(wave_sum(oa * oa + ob * ob) * (1.0f / 128.0f) + EPS);
            const float ya = oa * rstd * a.hg_onorm_g[lane] * bf2f(G[hb + lane]), yb = ob * rstd * a.hg_onorm_g[64 + lane] * bf2f(G[hb + 64 + lane]);
            YM[(size_t)row * 1024 + h * 128 + lane] = (unsigned short)f2bf(ya); YM[(size_t)row * 1024 + h * 128 + 64 + lane] = (unsigned short)f2bf(yb); }
    }
    __syncthreads();
}

__device__ __forceinline__ void scan_phase(const Args& a, int tid) {
    unsigned char* ws = a.ws; const float* DS = (const float*)(ws + WS_DS); const float* DSM = (const float*)(ws + OFF_DSM); const float* DEC = (const float*)(ws + WS_DEC); bf16* SST = (bf16*)(ws + WS_SST);
    for (int e = blockIdx.x * NTHR + tid; e < NB * 4 * 128 * 32; e += gridDim.x * NTHR) {
        const int d4 = (e & 31) * 4, v = (e >> 5) & 127, h = (e >> 12) & 3, b = e >> 14;
        f32x4 S = *(const f32x4*)(DSM + (size_t)h * 16384 + v * 128 + d4);
#pragma unroll 4
        for (int n = 0; n < NCH; ++n) { const size_t it = ((size_t)(b * 32 + n) * 4 + h) * 16384 + v * 128 + d4;
            const f32x4 ds = *(const f32x4*)(DS + it), dc = *(const f32x4*)(DEC + (size_t)(b * 32 + n) * 512 + h * 128 + d4);
            *(v2u*)(SST + it) = (v2u){pk2(S[0], S[1]), pk2(S[2], S[3])};
            S = S * dc + ds; }
        float* so = a.out + O_SHP + ((size_t)(b * 4 + h) * 128 + d4) * 128 + v;
        so[0] = S[0]; so[128] = S[1]; so[256] = S[2]; so[384] = S[3];
    }
}

__device__ __forceinline__ void ointer_item(const Args& a, int item, int lane, int wave) {
    unsigned char* ws = a.ws; const bf16* QD = (const bf16*)(ws + WS_QD); const bf16* SST = (const bf16*)(ws + WS_SST); const bf16* OI = (const bf16*)(ws + WS_OI); const bf16* G = (const bf16*)(ws + WS_G); bf16* YM = (bf16*)(ws + WS_YM);
    const int bn = item >> 1, h = (item & 1) * 2 + (wave >> 2), tt = wave & 3, fr = lane & 15, fq = lane >> 4;
    const int row = bn * 64 + 16 * tt + fr; const size_t hb = (size_t)row * 512 + h * 128;
    bf16x8 fb[4];
#pragma unroll
    for (int ks = 0; ks < 4; ++ks) fb[ks] = *(const bf16x8*)(QD + hb + 32 * ks + 8 * fq);
    const bf16* Sb = SST + ((size_t)bn * 4 + h) * 16384;
    f32x4 o[8]; float ss = 0.f;
#pragma unroll
    for (int vt = 0; vt < 8; ++vt) { f32x4 acc = {0.f, 0.f, 0.f, 0.f};
#pragma unroll
        for (int ks = 0; ks < 4; ++ks) { const bf16x8 fa = *(const bf16x8*)(Sb + (size_t)(16 * vt + fr) * 128 + 32 * ks + 8 * fq); acc = __builtin_amdgcn_mfma_f32_16x16x32_bf16(fa, fb[ks], acc, 0, 0, 0); }
        const v2u oi = *(const v2u*)(OI + hb + 16 * vt + 4 * fq);
        acc[0] += bflo(oi.x); acc[1] += bfhi(oi.x); acc[2] += bflo(oi.y); acc[3] += bfhi(oi.y);
        ss += (acc[0] * acc[0] + acc[1] * acc[1]) + (acc[2] * acc[2] + acc[3] * acc[3]); o[vt] = acc; }
    ss += __shfl_xor(ss, 16); ss += __shfl_xor(ss, 32);
    const float rstd = __builtin_amdgcn_rsqf(ss * (1.0f / 128.0f) + EPS);
#pragma unroll
    for (int vt = 0; vt < 8; ++vt) { const v2u gg = *(const v2u*)(G + hb + 16 * vt + 4 * fq); const f32x4 og = *(const f32x4*)(a.hg_onorm_g + 16 * vt + 4 * fq);
        const float y0 = o[vt][0] * rstd * og[0] * bflo(gg.x), y1 = o[vt][1] * rstd * og[1] * bfhi(gg.x), y2 = o[vt][2] * rstd * og[2] * bflo(gg.y), y3 = o[vt][3] * rstd * og[3] * bfhi(gg.y);
        *(v2u*)(YM + (size_t)row * 1024 + h * 128 + 16 * vt + 4 * fq) = (v2u){pk2(y0, y1), pk2(y2, y3)}; }
}

__device__ __forceinline__ void final_norm(const Args& a, int lane, int wave) {
    const float* SS3 = (const float*)(a.ws + OFF_SS3);
    f32x4 g[4];
#pragma unroll
    for (int j = 0; j < 4; ++j) g[j] = ((const f32x4*)a.final_g)[lane + 64 * j];
    for (int m = blockIdx.x * NWAVES + wave; m < ROWS_REAL + NSAMP; m += gridDim.x * NWAVES) {
        const int row = m < ROWS_REAL ? m : ROW_SAMP + (m - ROWS_REAL);
        f32x4* p = (f32x4*)(a.out + (size_t)m * D) + lane;
        const float rs = __builtin_amdgcn_rsqf(SS3[row] * (1.0f / D) + EPS);
#pragma unroll
        for (int j = 0; j < 4; ++j) p[64 * j] = p[64 * j] * rs * g[j];
    }
}

__global__ void __launch_bounds__(NTHR, 2) hymba_fwd(Args args) {
    extern __shared__ __attribute__((aligned(16))) unsigned char lds_raw[];
    LAS unsigned char* lds = (LAS unsigned char*)lds_raw;
    const int tid = threadIdx.x, lane = tid & 63, wave = __builtin_amdgcn_readfirstlane(tid >> 6);
    const int G = gridDim.x, bx = blockIdx.x;
    unsigned char* ws = args.ws;
    const int lo = args.ph_lo, hi = args.ph_hi;
#ifndef PHMASK
#define PHMASK 0x1ff
#endif
#define IN(k) (((PHMASK >> (k)) & 1) && lo <= (k) && (k) < hi)
#define SEAM(k) do { if (IN(k) && IN((k) + 1)) { cg::this_grid().sync(); } } while (0)
    if (IN(0)) { p0_prologue(args, lds, tid, lane, wave); }
    SEAM(0);
    if (IN(1)) {
        pg8::Gemm g{(const pg8::bf16_t*)(ws + WS_XB), (const pg8::bf16_t*)(ws + WS_WIN), MROWS, NIN, D}; pg8::StaticOrder S; S.init(MROWS, NIN, G, bx);
        pg8::EpiIn E{(bf16*)(ws + WS_Q), (bf16*)(ws + WS_V), (bf16*)(ws + WS_G), (bf16*)(ws + WS_GLU), (float*)(ws + WS_LF), (const float*)(ws + OFF_RS1), (const float*)(ws + OFF_LB)};
        pg8::gemm_phase<pg8::EpiIn, pg8::StaticOrder, true, true>(lds, g, S, E);
    }
    SEAM(1);
    if (IN(2)) {
#ifndef P2SEL
#define P2SEL 7
#endif
        if (P2SEL & 1) for (int it = bx; it < 1028; it += G) hgrn_chunk_item(args, lds, it, tid, lane, wave);
        if ((P2SEL & 2) && bx < 256) conv_item(args, lds, bx, tid, lane, wave);
        if (P2SEL & 4) for (int it = bx; it < NSAMP; it += G) sample_item(args, lds, it, tid, lane, wave);
    }
    SEAM(2);
    if (IN(3)) { scan_phase(args, tid); }
    SEAM(3);
    if (IN(4)) { for (int it = bx; it < NB * NCH * 2; it += G) ointer_item(args, it, lane, wave); }
    SEAM(4);
    if (IN(5)) {
        pg8::Gemm g{(const pg8::bf16_t*)(ws + WS_YM), (const pg8::bf16_t*)(ws + WS_WOUT), MROWS, D, D}; pg8::StaticOrder S; S.init(MROWS, D, G, bx);
        pg8::EpiOut E{args.x_prompt, args.meta, args.x_sample, (float*)(ws + WS_H1), (bf16*)(ws + WS_HB), (float*)(ws + OFF_SS2)};
        pg8::gemm_phase<pg8::EpiOut, pg8::StaticOrder, true, true>(lds, g, S, E);
    }
    SEAM(5);
    if (IN(6)) {
        pg8::Gemm g{(const pg8::bf16_t*)(ws + WS_HB), (const pg8::bf16_t*)(ws + WS_WUP), MROWS, FF, D}; pg8::StaticOrder S; S.init(MROWS, FF, G, bx);
        pg8::EpiUp E{(bf16*)(ws + WS_HID), (const float*)(ws + OFF_SS2)};
        pg8::gemm_phase<pg8::EpiUp, pg8::StaticOrder, true, true>(lds, g, S, E);
    }
    SEAM(6);
    if (IN(7)) {
        pg8::Gemm g{(const pg8::bf16_t*)(ws + WS_HID), (const pg8::bf16_t*)(ws + WS_WDN), MROWS, D, FF}; pg8::StaticOrder S; S.init(MROWS, D, G, bx);
        pg8::EpiDown E{(const float*)(ws + WS_H1), args.out + O_YP, args.out + O_YS, (float*)(ws + OFF_SS3)};
        pg8::gemm_phase<pg8::EpiDown, pg8::StaticOrder, true, true>(lds, g, S, E);
    }
    SEAM(7);
    if (IN(8)) { final_norm(args, lane, wave); }
#undef IN
#undef SEAM
}

#ifndef N_LAUNCH_MODE
#define N_LAUNCH_MODE 1
#endif
extern "C" void kernel_launch(void* const* d_in, const int* in_sizes, int n_in, void* d_out, int out_size, void* d_ws, size_t ws_size, hipStream_t stream) {
    static int grid = 0;
    if (grid == 0) {
        int dev = 0, cus = 0, per_cu = 0;
        hipGetDevice(&dev); hipDeviceGetAttribute(&cus, hipDeviceAttributeMultiprocessorCount, dev);
        hipFuncSetAttribute((const void*)hymba_fwd, hipFuncAttributeMaxDynamicSharedMemorySize, LDS_BYTES);
        hipOccupancyMaxActiveBlocksPerMultiprocessor(&per_cu, (const void*)hymba_fwd, NTHR, LDS_BYTES);
        if (per_cu < 1) per_cu = 1;
        grid = cus * per_cu;
        if (ws_size < WS_END || n_in != 18) { fprintf(stderr, "kernel_launch: ws %zu < %zu or n_in %d\n", ws_size, (size_t)WS_END, n_in); }
        fprintf(stderr, "kernel_launch: grid %d (cus %d x %d)\n", grid, cus, per_cu);
    }
    Args a{};
    const float** pp = (const float**)&a;
    for (int i = 0; i < 18; ++i) pp[i] = (const float*)d_in[i];
    a.out = (float*)d_out; a.ws = (unsigned char*)d_ws; a.pad = 0;
#if N_LAUNCH_MODE == 1
    a.ph_lo = 0; a.ph_hi = 9; a.coop = 1;
    void* kargs[] = {&a};
    hipError_t e = hipLaunchCooperativeKernel((const void*)hymba_fwd, dim3(grid), dim3(NTHR), kargs, LDS_BYTES, stream);
    if (e != hipSuccess) fprintf(stderr, "cooperative launch failed: %s (grid %d)\n", hipGetErrorString(e), grid);
#else
    for (int p = 0; p < 9; ++p) { a.ph_lo = p; a.ph_hi = p + 1; a.coop = 0; hipLaunchKernelGGL(hymba_fwd, dim3(grid), dim3(NTHR), LDS_BYTES, stream, a); }
#endif
}
```

```cpp
#include <hip/hip_runtime.h>
#include <hip/hip_cooperative_groups.h>
#include <cstdio>
#include <cstdint>
namespace cg = cooperative_groups;
namespace pg8 {
#define PG8_LAS __attribute__((address_space(3)))
typedef unsigned short bf16_t;
typedef short bf16x8 __attribute__((ext_vector_type(8)));
typedef float f32x4 __attribute__((ext_vector_type(4)));
typedef unsigned u32x4 __attribute__((ext_vector_type(4)));
constexpr int BM = 256, BK = 64, HALF = 128, HTB = HALF * BK * 2  , STAGE_BYTES = 8 * HTB, NXCD = 8, WGM = 8;

__host__ __device__ __forceinline__ int lds_byte(int r, int c) { const int st = (r >> 4) * 2 + (c >> 5), rr = r & 15, cc = c & 31, ob = rr * 64 + cc * 2; return st * 1024 + (ob ^ (((ob >> 9) & 1) << 5)); }
__host__ __device__ __forceinline__ void stage_rc(int b, int& R, int& C) { const int st = b / 1024, sb = b % 1024, swz = sb ^ (((sb >> 9) & 1) << 5); R = (st >> 1) * 16 + swz / 64; C = (st & 1) * 32 + (swz % 64) / 2; }
__host__ __device__ __forceinline__ int perm32(int rho) { const int n = rho >> 4, i = rho & 15; return 8 * (i >> 2) + 4 * n + (i & 3); }

struct Unit { int pm, pn; };
struct Gemm { const bf16_t* A; const bf16_t* Bt; int M, N, K; };

struct StaticOrder {
    int nM, nN, nwg, G, c;
    __host__ __device__ void init(int M, int N, int G_, int c_) { nM = M / BM; nN = N / BM; nwg = nM * nN; G = G_; c = c_; }
    __host__ __device__ bool next(int i, Unit& u) const {
        const long L = (long)i * G + c; if (L >= nwg) return false;
        int wgid = (int)L; { const int q = nwg / NXCD, r = nwg % NXCD, xcd = wgid % NXCD, off = wgid / NXCD; wgid = (xcd < r ? xcd * (q + 1) : r * (q + 1) + (xcd - r) * q) + off; }
        const int nig = WGM * nN, gid = wgid / nig, fm = gid * WGM, gsz = (nM - fm) < WGM ? (nM - fm) : WGM;
        u.pm = fm + ((wgid % nig) % gsz); u.pn = (wgid % nig) / gsz; return true;
    }
    __device__ __forceinline__ void a_ready(const Unit&) const {}
    __device__ __forceinline__ void done(const Unit&) const {}
};

__device__ __forceinline__ unsigned cvt_pk_bf16(float lo, float hi) { unsigned r; asm volatile("v_cvt_pk_bf16_f32 %0, %1, %2" : "=v"(r) : "v"(lo), "v"(hi)); return r; }
typedef float f32x2 __attribute__((ext_vector_type(2)));
constexpr int ROWS_REAL = 16384, ROW_META = 16384, ROW_SAMP = 16400, ROWS_USED = 16528, MROWS = 16640;
__device__ __forceinline__ float sigm(float x) { return __builtin_amdgcn_rcpf(1.0f + __expf(-x)); }
__device__ __forceinline__ float silu_f(float x) { return x * sigm(x); }
__device__ __forceinline__ u32x4 pack8(const f32x4 a, const f32x4 b) { u32x4 w; w.x = cvt_pk_bf16(a[0], a[1]); w.y = cvt_pk_bf16(a[2], a[3]); w.z = cvt_pk_bf16(b[0], b[1]); w.w = cvt_pk_bf16(b[2], b[3]); return w; }

struct EpiIn {
    static constexpr bool PERM = true, AFTER_DRAIN = false;
    bf16_t *Q, *V, *G, *GLU; float* LF; const float* rs1; const float* LB;
    __device__ __forceinline__ void operator()(const f32x4 (&acc)[2][2][4][2], const Unit& u, int wr, int wc, int fr, int fq) const {
        const int row0 = u.pm * BM + wr * 64 + fr; const int pn = u.pn;
        if (pn < 8) {
            const int type = pn >> 1; const int colb = (pn & 1) * 256 + wc * 32 + 8 * fq;
            f32x4 lb[2][2];
            if (type == 1) {
#pragma unroll
                for (int bj = 0; bj < 2; ++bj)
#pragma unroll
                    for (int n = 0; n < 2; ++n) lb[bj][n] = *(const f32x4*)(LB + colb + bj * HALF + 4 * n);
            }
#pragma unroll
            for (int ai = 0; ai < 2; ++ai)
#pragma unroll
                for (int m = 0; m < 4; ++m) { const int row = row0 + ai * HALF + m * 16; const float rs = rs1[row];
#pragma unroll
                    for (int bj = 0; bj < 2; ++bj) { f32x4 v0 = acc[ai][bj][m][0] * rs, v1 = acc[ai][bj][m][1] * rs; const size_t off = (size_t)row * 512 + colb + bj * HALF;
                        if (type == 1) {
#pragma unroll
                            for (int i = 0; i < 4; ++i) { const float l0 = lb[bj][0][i], l1 = lb[bj][1][i];
                                v0[i] = __logf(l0 + (1.0f - l0) * sigm(v0[i])); v1[i] = __logf(l1 + (1.0f - l1) * sigm(v1[i])); }
                            *(f32x4*)(LF + off) = v0; *(f32x4*)(LF + off + 4) = v1;
                        } else {
                            if (type != 2) {
#pragma unroll
                                for (int i = 0; i < 4; ++i) { v0[i] = silu_f(v0[i]); v1[i] = silu_f(v1[i]); } }
                            const int sel = (type == 0) ? 0 : (type == 2 ? 1 : 3);
                            bf16_t* dst = Q + (size_t)sel * ((size_t)MROWS * 512);
                            *(u32x4*)(dst + off) = pack8(v0, v1);
                        } } }
        } else {
            const int colb = (pn - 8) * 128 + wc * 32 + 8 * fq;
#pragma unroll
            for (int ai = 0; ai < 2; ++ai)
#pragma unroll
                for (int m = 0; m < 4; ++m) { const int row = row0 + ai * HALF + m * 16; const float rs = rs1[row];
                    f32x4 g0, g1;
#pragma unroll
                    for (int i = 0; i < 4; ++i) { g0[i] = acc[ai][0][m][0][i] * rs * sigm(acc[ai][1][m][0][i] * rs); g1[i] = acc[ai][0][m][1][i] * rs * sigm(acc[ai][1][m][1][i] * rs); }
                    *(u32x4*)(GLU + (size_t)row * 512 + colb) = pack8(g0, g1); }
        }
    }
};
__device__ __forceinline__ const float* resid_row(const float* xp, const float* meta, const float* xs, int row) {
    return row < ROWS_REAL ? xp + (size_t)row * 1024 : (row < ROW_SAMP ? meta + (size_t)(row - ROW_META) * 1024 : (row < ROWS_USED ? xs + (size_t)(row - ROW_SAMP) * 1024 : nullptr));
}
struct EpiOut {
    static constexpr bool PERM = true, AFTER_DRAIN = false;
    const float *xp, *meta, *xs; float* H1; bf16_t* HB; float* SS;
    __device__ __forceinline__ void operator()(const f32x4 (&acc)[2][2][4][2], const Unit& u, int wr, int wc, int fr, int fq) const {
        const int row0 = u.pm * BM + wr * 64 + fr; const int colb = u.pn * BM + wc * 32 + 8 * fq;
#pragma unroll
        for (int ai = 0; ai < 2; ++ai)
#pragma unroll
            for (int m = 0; m < 4; ++m) { const int row = row0 + ai * HALF + m * 16; const float* rp = resid_row(xp, meta, xs, row); float ss = 0.f;
#pragma unroll
                for (int bj = 0; bj < 2; ++bj) { const int col = colb + bj * HALF; f32x4 v0 = acc[ai][bj][m][0], v1 = acc[ai][bj][m][1];
                    if (rp) { v0 += *(const f32x4*)(rp + col); v1 += *(const f32x4*)(rp + col + 4); }
                    ss += (v0[0] * v0[0] + v0[1] * v0[1]) + (v0[2] * v0[2] + v0[3] * v0[3]) + (v1[0] * v1[0] + v1[1] * v1[1]) + (v1[2] * v1[2] + v1[3] * v1[3]);
                    const size_t off = (size_t)row * 1024 + col;
                    *(f32x4*)(H1 + off) = v0; *(f32x4*)(H1 + off + 4) = v1; *(u32x4*)(HB + off) = pack8(v0, v1); }
                ss += __shfl_xor(ss, 16); ss += __shfl_xor(ss, 32);
                if (fq == 0) atomicAdd(SS + row, ss); }
    }
};
struct EpiUp {
    static constexpr bool PERM = true, AFTER_DRAIN = false;
    bf16_t* HID; const float* SS;
    __device__ __forceinline__ void operator()(const f32x4 (&acc)[2][2][4][2], const Unit& u, int wr, int wc, int fr, int fq) const {
        const int row0 = u.pm * BM + wr * 64 + fr; const int colb = u.pn * BM + wc * 32 + 8 * fq;
#pragma unroll
        for (int ai = 0; ai < 2; ++ai)
#pragma unroll
            for (int m = 0; m < 4; ++m) { const int row = row0 + ai * HALF + m * 16; const float rs = __builtin_amdgcn_rsqf(SS[row] * (1.0f / 1024.0f) + 1e-6f);
#pragma unroll
                for (int bj = 0; bj < 2; ++bj) { f32x4 v0 = acc[ai][bj][m][0] * rs, v1 = acc[ai][bj][m][1] * rs;
#pragma unroll
                    for (int i = 0; i < 4; ++i) { const float a = fmaxf(v0[i], 0.f), b = fmaxf(v1[i], 0.f); v0[i] = a * a; v1[i] = b * b; }
                    *(u32x4*)(HID + (size_t)row * 4096 + colb + bj * HALF) = pack8(v0, v1); } }
    }
};
struct EpiDown {
    static constexpr bool PERM = true, AFTER_DRAIN = false;
    const float* H1; float* yp; float* ys; float* SS;
    __device__ __forceinline__ void operator()(const f32x4 (&acc)[2][2][4][2], const Unit& u, int wr, int wc, int fr, int fq) const {
        const int row0 = u.pm * BM + wr * 64 + fr; const int colb = u.pn * BM + wc * 32 + 8 * fq;
#pragma unroll
        for (int ai = 0; ai < 2; ++ai)
#pragma unroll
            for (int m = 0; m < 4; ++m) { const int row = row0 + ai * HALF + m * 16;
                float* op = row < ROWS_REAL ? yp + (size_t)row * 1024 : ((row >= ROW_SAMP && row < ROWS_USED) ? ys + (size_t)(row - ROW_SAMP) * 1024 : nullptr);
                if (op) { float ss = 0.f;
#pragma unroll
                    for (int bj = 0; bj < 2; ++bj) { const int col = colb + bj * HALF; const size_t off = (size_t)row * 1024 + col;
                        const f32x4 v0 = acc[ai][bj][m][0] + *(const f32x4*)(H1 + off), v1 = acc[ai][bj][m][1] + *(const f32x4*)(H1 + off + 4);
                        ss += (v0[0] * v0[0] + v0[1] * v0[1]) + (v0[2] * v0[2] + v0[3] * v0[3]) + (v1[0] * v1[0] + v1[1] * v1[1]) + (v1[2] * v1[2] + v1[3] * v1[3]);
                        *(f32x4*)(op + col) = v0; *(f32x4*)(op + col + 4) = v1; }
                    ss += __shfl_xor(ss, 16); ss += __shfl_xor(ss, 32);
                    if (fq == 0) atomicAdd(SS + row, ss); } }
    }
};
template <class Epi, class Sched, bool ALIGN_EPI = false, bool SP2 = false>
__device__ __forceinline__ void gemm_phase(PG8_LAS unsigned char* lds, const Gemm g, const Sched& S, const Epi& E) {
    const int tid = threadIdx.x, wid = __builtin_amdgcn_readfirstlane(tid >> 6), lane = tid & 63, wr = wid >> 2, wc = wid & 3, fr = lane & 15, fq = lane >> 4;
    const int K = g.K, nt = K / BK;
    unsigned voffA[2], voffB[2];
#pragma unroll
    for (int i = 0; i < 2; ++i) { int R, C; stage_rc(tid * 16 + i * 8192, R, C); const int Rb = Epi::PERM ? ((R & ~31) + perm32(R & 31)) : R;
        voffA[i] = (unsigned)(R * K + C) * 2u; voffB[i] = (unsigned)(Rb * K + C) * 2u; }
    const size_t kstep = (size_t)(BK * 2);
    const size_t hstep = (size_t)HALF * K * 2;
    const size_t tstep = 2 * hstep;
    const unsigned ldsw = (unsigned)wid * 1024u;
    const int aoff = lds_byte(wr * 64 + fr, fq * 8), boff = lds_byte(wc * 32 + fr, fq * 8);
#define PG8_SA(b, h) (((b) * 2 + (h)) * HTB)
#define PG8_SB(b, h) ((4 + (b) * 2 + (h)) * HTB)
#define PG8_STAGE(bufoff, gbase, voff) do { _Pragma("unroll") for (int _i = 0; _i < 2; ++_i) \
        __builtin_amdgcn_global_load_lds((const unsigned*)((const char*)(gbase) + (voff)[_i]), (PG8_LAS unsigned*)(lds + (bufoff) + ldsw + _i * 8192), 16, 0, 0); } while (0)
#define PG8_LDA(dst, b, h) do { _Pragma("unroll") for (int m = 0; m < 4; ++m) _Pragma("unroll") for (int k = 0; k < 2; ++k) dst[m][k] = *(const PG8_LAS bf16x8*)(lds + PG8_SA(b, h) + aoff + m * 2048 + k * 1024); } while (0)
#define PG8_LDB(dst, b, h) do { _Pragma("unroll") for (int n = 0; n < 2; ++n) _Pragma("unroll") for (int k = 0; k < 2; ++k) dst[n][k] = *(const PG8_LAS bf16x8*)(lds + PG8_SB(b, h) + boff + n * 2048 + k * 1024); } while (0)
#define PG8_MMA(ai, bj, At, Bt) do { __builtin_amdgcn_s_setprio(1); _Pragma("unroll") for (int m = 0; m < 4; ++m) _Pragma("unroll") for (int n = 0; n < 2; ++n) _Pragma("unroll") for (int k = 0; k < 2; ++k) \
        acc[ai][bj][m][n] = __builtin_amdgcn_mfma_f32_16x16x32_bf16(Bt[n][k], At[m][k], acc[ai][bj][m][n], 0, 0, 0); __builtin_amdgcn_s_setprio(0); } while (0)
#define PG8_WAIT_V(n) asm volatile("s_waitcnt vmcnt(" #n ")" ::: "memory")
#define PG8_WAIT_L(n) asm volatile("s_waitcnt lgkmcnt(" #n ")" ::: "memory")
#define PG8_BAR __builtin_amdgcn_s_barrier()
#define PG8_SCHED __builtin_amdgcn_sched_barrier(0)
    Unit cur, nxt; int ui = 0;
    if (!S.next(0, cur)) return;
    f32x4 acc[2][2][4][2];
#pragma unroll
    for (int a = 0; a < 2; ++a)
#pragma unroll
        for (int b = 0; b < 2; ++b)
#pragma unroll
            for (int m = 0; m < 4; ++m)
#pragma unroll
                for (int n = 0; n < 2; ++n) acc[a][b][m][n] = (f32x4){0.f, 0.f, 0.f, 0.f};
    bf16x8 At[4][2], B0[2][2], B1[2][2];
    const char* cA = (const char*)g.A + (size_t)cur.pm * tstep; const char* cB = (const char*)g.Bt + (size_t)cur.pn * tstep;
    S.a_ready(cur);
    if constexpr (SP2) {
        PG8_STAGE(PG8_SB(0, 0), cB, voffB); PG8_STAGE(PG8_SB(0, 1), cB + hstep, voffB); PG8_STAGE(PG8_SA(0, 0), cA, voffA); PG8_STAGE(PG8_SA(0, 1), cA + hstep, voffA);
        if (wr == 1) PG8_BAR;
        PG8_WAIT_V(2); PG8_BAR;
        PG8_STAGE(PG8_SB(1, 0), cB + kstep, voffB); PG8_STAGE(PG8_SA(1, 0), cA + kstep, voffA); PG8_STAGE(PG8_SB(1, 1), cB + hstep + kstep, voffB);
        PG8_WAIT_V(6); PG8_BAR;
    } else {
        PG8_STAGE(PG8_SB(0, 0), cB, voffB); PG8_STAGE(PG8_SA(0, 0), cA, voffA); PG8_STAGE(PG8_SB(0, 1), cB + hstep, voffB); PG8_STAGE(PG8_SA(0, 1), cA + hstep, voffA);
        if (wr == 1) PG8_BAR;
        PG8_WAIT_V(4); PG8_BAR;
        PG8_STAGE(PG8_SB(1, 0), cB + kstep, voffB); PG8_STAGE(PG8_SA(1, 0), cA + kstep, voffA); PG8_STAGE(PG8_SB(1, 1), cB + hstep + kstep, voffB);
        PG8_WAIT_V(6); PG8_BAR;
    }
    for (;;) {
        const bool has_next = S.next(ui + 1, nxt);
        const char* nA = has_next ? (const char*)g.A + (size_t)nxt.pm * tstep : cA; const char* nB = has_next ? (const char*)g.Bt + (size_t)nxt.pn * tstep : cB;
        for (int t = 0; t < nt; t += 2) {
            const bool last = (t == nt - 2);
            const char* a1 = cA + (size_t)(t + 1) * kstep;
            const char* a2 = last ? nA : cA + (size_t)(t + 2) * kstep; const char* b2 = last ? nB : cB + (size_t)(t + 2) * kstep;
            const char* a3 = a2 + kstep; const char* b3 = b2 + kstep;
            if (last && has_next) S.a_ready(nxt);
            if constexpr (SP2) {
            PG8_LDB(B0, 0, 0); PG8_LDB(B1, 0, 1); PG8_SCHED; PG8_LDA(At, 0, 0); PG8_STAGE(PG8_SA(1, 1), a1 + hstep, voffA);
            PG8_WAIT_V(8); PG8_WAIT_L(0); PG8_BAR; PG8_MMA(0, 0, At, B0); PG8_MMA(0, 1, At, B1); PG8_BAR; PG8_SCHED;
            PG8_LDA(At, 0, 1); PG8_STAGE(PG8_SB(0, 0), b2, voffB); PG8_STAGE(PG8_SB(0, 1), b2 + hstep, voffB); PG8_STAGE(PG8_SA(0, 0), a2, voffA);
            PG8_WAIT_V(8); PG8_WAIT_L(0); PG8_BAR; PG8_MMA(1, 0, At, B0); PG8_MMA(1, 1, At, B1); PG8_BAR; PG8_SCHED;
            PG8_LDB(B0, 1, 0); PG8_LDB(B1, 1, 1); PG8_SCHED; PG8_LDA(At, 1, 0); PG8_STAGE(PG8_SA(0, 1), a2 + hstep, voffA);
            PG8_WAIT_V(8); PG8_WAIT_L(0); PG8_BAR; PG8_MMA(0, 0, At, B0); PG8_MMA(0, 1, At, B1); PG8_BAR; PG8_SCHED;
            PG8_LDA(At, 1, 1); PG8_STAGE(PG8_SB(1, 0), b3, voffB); PG8_STAGE(PG8_SB(1, 1), b3 + hstep, voffB); PG8_STAGE(PG8_SA(1, 0), a3, voffA);
            PG8_WAIT_V(8); PG8_WAIT_L(0); PG8_BAR; PG8_MMA(1, 0, At, B0); PG8_MMA(1, 1, At, B1); PG8_BAR; PG8_SCHED;
            } else {
            PG8_LDB(B0, 0, 0); PG8_SCHED; PG8_LDA(At, 0, 0); PG8_STAGE(PG8_SA(1, 1), a1 + hstep, voffA);
            PG8_WAIT_L(8); PG8_BAR; PG8_WAIT_L(0); PG8_MMA(0, 0, At, B0); PG8_BAR; PG8_SCHED;
            PG8_LDB(B1, 0, 1); PG8_STAGE(PG8_SB(0, 0), b2, voffB);
            PG8_BAR; PG8_WAIT_L(0); PG8_MMA(0, 1, At, B1); PG8_BAR;
            PG8_LDA(At, 0, 1); PG8_STAGE(PG8_SA(0, 0), a2, voffA);
            PG8_BAR; PG8_WAIT_L(0); PG8_MMA(1, 0, At, B0); PG8_BAR; PG8_SCHED;
            PG8_STAGE(PG8_SB(0, 1), b2 + hstep, voffB);
            PG8_WAIT_V(6); PG8_BAR; PG8_MMA(1, 1, At, B1); PG8_BAR;
            PG8_LDB(B0, 1, 0); PG8_SCHED; PG8_LDA(At, 1, 0); PG8_STAGE(PG8_SA(0, 1), a2 + hstep, voffA);
            PG8_WAIT_L(8); PG8_BAR; PG8_WAIT_L(0); PG8_MMA(0, 0, At, B0); PG8_BAR; PG8_SCHED;
            PG8_LDB(B1, 1, 1); PG8_STAGE(PG8_SB(1, 0), b3, voffB);
            PG8_BAR; PG8_WAIT_L(0); PG8_MMA(0, 1, At, B1); PG8_BAR;
            PG8_LDA(At, 1, 1); PG8_STAGE(PG8_SA(1, 0), a3, voffA);
            PG8_BAR; PG8_WAIT_L(0); PG8_MMA(1, 0, At, B0); PG8_BAR; PG8_SCHED;
            PG8_STAGE(PG8_SB(1, 1), b3 + hstep, voffB);
            PG8_WAIT_V(6); PG8_BAR; PG8_MMA(1, 1, At, B1); PG8_BAR;
            }
        }
        if constexpr (ALIGN_EPI) { if (wr == 0) PG8_BAR; }
        if constexpr (!Epi::AFTER_DRAIN) { E(acc, cur, wr, wc, fr, fq); S.done(cur); }
        if (!has_next) break;
#pragma unroll
        for (int a = 0; a < 2; ++a)
#pragma unroll
            for (int b = 0; b < 2; ++b)
#pragma unroll
                for (int m = 0; m < 4; ++m)
#pragma unroll
                    for (int n = 0; n < 2; ++n) acc[a][b][m][n] = (f32x4){0.f, 0.f, 0.f, 0.f};
        cur = nxt; cA = nA; cB = nB; ++ui;
        if constexpr (ALIGN_EPI) { if (wr == 1) PG8_BAR; }
    }
    PG8_WAIT_V(0);
    if constexpr (!ALIGN_EPI) { if (wr == 0) PG8_BAR; }
    PG8_BAR;
    if constexpr (Epi::AFTER_DRAIN) { E.fused(acc, cur, wr, wc, fr, fq, lds, wid, lane); S.done(cur); }
#undef PG8_SA
#undef PG8_SB
#undef PG8_STAGE
#undef PG8_LDA
#undef PG8_LDB
#undef PG8_MMA
#undef PG8_WAIT_V
#undef PG8_WAIT_L
#undef PG8_BAR
#undef PG8_SCHED
}
}

#define LAS __attribute__((address_space(3)))
typedef unsigned short bf16;
typedef unsigned v4u __attribute__((ext_vector_type(4)));
typedef unsigned v2u __attribute__((ext_vector_type(2)));
typedef float f32x4 __attribute__((ext_vector_type(4)));
typedef short bf16x8 __attribute__((ext_vector_type(8)));
constexpr int NWAVES = 8, NTHR = 512;
constexpr int D = 1024, NIN = 3072, FF = 4096, HW = 512;
constexpr int ROWS_REAL = pg8::ROWS_REAL, ROW_META = pg8::ROW_META, ROW_SAMP = pg8::ROW_SAMP, ROWS_USED = pg8::ROWS_USED, MROWS = pg8::MROWS;
constexpr int NB = 8, SEQ = 2048, NCH = 32, NSAMP = 128;
constexpr float EPS = 1e-6f;
constexpr int LDS_BYTES = 147456;

constexpr size_t KiB = 1024, MiB = 1u << 20;
constexpr size_t OFF_SS2 = 0, OFF_SS3 = 128 * KiB, OFF_RS1 = 256 * KiB, OFF_LB = 384 * KiB, OFF_DSM = 512 * KiB;
constexpr size_t WS_WIN = 1 * MiB, WS_WOUT = 7 * MiB, WS_WUP = 9 * MiB, WS_WDN = 17 * MiB;
constexpr size_t WS_XB = 25 * MiB;
constexpr size_t WS_DS = 25 * MiB;
constexpr size_t WS_DEC = 89 * MiB;
constexpr size_t WS_LF = 89 * MiB + 512 * KiB;
constexpr size_t WS_SST = WS_LF;
constexpr size_t SZH = (size_t)MROWS * 512 * 2;
constexpr size_t WS_Q = 122 * MiB, WS_V = WS_Q + SZH, WS_GLU = WS_V + SZH, WS_G = WS_GLU + SZH, WS_QD = WS_G + SZH, WS_OI = WS_QD + SZH, WS_YM = WS_OI + SZH;
constexpr size_t WS_H1 = 25 * MiB;
constexpr size_t WS_HB = 90 * MiB;
constexpr size_t WS_HID = 122 * MiB + 512 * KiB;
constexpr size_t WS_END = 253 * MiB;
static_assert(WS_YM + 2 * SZH <= 252 * MiB + 1 && WS_HID + (size_t)MROWS * FF * 2 <= WS_END && WS_LF + (size_t)MROWS * 512 * 4 <= WS_Q, "ws map");

struct Args {
    const float *x_prompt, *x_sample, *state_hgrn, *state_conv, *meta, *hg_lb, *norm1_g, *w_in, *hg_onorm_g, *conv_w, *conv_b, *conv_ln_g, *conv_ln_b, *w_out, *norm2_g, *w_up, *w_down, *final_g;
    float* out; unsigned char* ws; int ph_lo, ph_hi, coop, pad;
};
constexpr size_t O_YP = 0, O_YS = (size_t)ROWS_REAL * D, O_SHP = O_YS + (size_t)NSAMP * D, O_SCP = O_SHP + (size_t)NB * 4 * 128 * 128, O_SHS = O_SCP + (size_t)NB * 30 * 512, O_SCS = O_SHS + (size_t)NSAMP * 4 * 128 * 128;

__device__ __forceinline__ unsigned f2bf(float f) { unsigned u = __builtin_bit_cast(unsigned, f); return (u + 0x7fffu + ((u >> 16) & 1u)) >> 16; }
__device__ __forceinline__ unsigned pk2(float lo, float hi) { return f2bf(lo) | (f2bf(hi) << 16); }
__device__ __forceinline__ float bf2f(unsigned short b) { return __builtin_bit_cast(float, (unsigned)b << 16); }
__device__ __forceinline__ float bflo(unsigned w) { return __builtin_bit_cast(float, w << 16); }
__device__ __forceinline__ float bfhi(unsigned w) { return __builtin_bit_cast(float, w & 0xffff0000u); }
__device__ __forceinline__ float wave_sum(float v) {
#pragma unroll
    for (int o = 1; o < 64; o <<= 1) v += __shfl_xor(v, o);
    return v;
}
#define LDS_WAIT() asm volatile("s_waitcnt lgkmcnt(0)" ::: "memory")

template <bool IN_PERM>
__device__ __forceinline__ void p0_transpose_item(const float* W, const float* g, int K, int N, bf16* WT, LAS float* scr, int item, int lane) {
    const int nblk = N / 32, kb = item / nblk, nb = item % nblk, k0 = 64 * kb, n0 = 32 * nb;
    int s0 = n0;
    if (IN_PERM && n0 >= 2048) { const int j = (n0 - 2048) >> 8, w = (n0 - 2048) & 255; s0 = (w < 128) ? 2048 + 128 * j + w : 2560 + 128 * j + (w - 128); }
#pragma unroll 8
    for (int i = 0; i < 32; ++i) { const int kk = 2 * i + (lane >> 5); const float gg = g ? g[k0 + kk] : 1.0f; scr[kk * 33 + (lane & 31)] = gg * W[(size_t)(k0 + kk) * N + s0 + (lane & 31)]; }
    LDS_WAIT(); asm volatile("" ::: "memory");
    const int c = lane & 7;
#pragma unroll
    for (int j = 0; j < 4; ++j) { const int n = (lane >> 3) + 8 * j; const LAS float* s = scr + (8 * c) * 33 + n;
        v4u o; o.x = pk2(s[0 * 33], s[1 * 33]); o.y = pk2(s[2 * 33], s[3 * 33]); o.z = pk2(s[4 * 33], s[5 * 33]); o.w = pk2(s[6 * 33], s[7 * 33]);
        *(v4u*)(WT + (size_t)(n0 + n) * K + k0 + 8 * c) = o; }
    LDS_WAIT(); asm volatile("" ::: "memory");
}
__device__ __forceinline__ void p0_prologue(const Args& a, LAS unsigned char* lds, int tid, int lane, int wave) {
    unsigned char* ws = a.ws;
    const int gw = blockIdx.x * NWAVES + wave, NGW = gridDim.x * NWAVES; const int gt = blockIdx.x * NTHR + tid, NGT = gridDim.x * NTHR;
    float* SS2 = (float*)(ws + OFF_SS2); float* SS3 = (float*)(ws + OFF_SS3); float* RS1 = (float*)(ws + OFF_RS1); float* LB = (float*)(ws + OFF_LB);
    for (int i = gt; i < MROWS; i += NGT) { SS2[i] = 0.f; SS3[i] = 0.f; }
    if (gt < 512) { const float p0 = a.hg_lb[gt], p1 = a.hg_lb[512 + gt]; const float m = fmaxf(p0, p1), e0 = __expf(p0 - m), e1 = __expf(p1 - m); LB[gt] = e0 / (e0 + e1); }
    LAS float* scr = (LAS float*)(lds + wave * 16384);
    constexpr int I_IN = (D / 64) * (NIN / 32), I_OUT = (D / 64) * (D / 32), I_UP = (D / 64) * (FF / 32), I_DN = (FF / 64) * (D / 32);
    constexpr int NITEMS = I_IN + I_OUT + I_UP + I_DN;
    for (int it = gw; it < NITEMS; it += NGW) {
        int r = it;
        if (r < I_IN) { p0_transpose_item<true>(a.w_in, a.norm1_g, D, NIN, (bf16*)(ws + WS_WIN), scr, r, lane); continue; } r -= I_IN;
        if (r < I_OUT) { p0_transpose_item<false>(a.w_out, nullptr, D, D, (bf16*)(ws + WS_WOUT), scr, r, lane); continue; } r -= I_OUT;
        if (r < I_UP) { p0_transpose_item<false>(a.w_up, a.norm2_g, D, FF, (bf16*)(ws + WS_WUP), scr, r, lane); continue; } r -= I_UP;
        p0_transpose_item<false>(a.w_down, nullptr, FF, D, (bf16*)(ws + WS_WDN), scr, r, lane);
    }
    bf16* XB = (bf16*)(ws + WS_XB);
    for (int m = gw; m < MROWS; m += NGW) {
        const float* xr = pg8::resid_row(a.x_prompt, a.meta, a.x_sample, m);
        unsigned long long* o8 = (unsigned long long*)(XB + (size_t)m * D) + lane;
        if (xr) { f32x4 v[4]; float s = 0.f;
#pragma unroll
            for (int j = 0; j < 4; ++j) { v[j] = ((const f32x4*)xr)[lane + 64 * j]; s += (v[j].x * v[j].x + v[j].y * v[j].y) + (v[j].z * v[j].z + v[j].w * v[j].w); }
            s = wave_sum(s);
            if (lane == 0) RS1[m] = __builtin_amdgcn_rsqf(s * (1.0f / D) + EPS);
#pragma unroll
            for (int j = 0; j < 4; ++j) o8[64 * j] = (unsigned long long)pk2(v[j].x, v[j].y) | ((unsigned long long)pk2(v[j].z, v[j].w) << 32);
        } else {
            if (lane == 0) RS1[m] = 0.f;
#pragma unroll
            for (int j = 0; j < 4; ++j) o8[64 * j] = 0ull;
        }
    }
}


template <int KSTEPS>
__device__ __forceinline__ void skinny_slab(const bf16* A, int lda, const bf16* Bt, int n0, LAS unsigned char* lds, int wave, int lane, f32x4& r0, f32x4& r1) {
    const int fr = lane & 15, fq = lane >> 4; const int K = KSTEPS * 256, kb = wave * (K / 8) + 8 * fq;
    const bf16* bp = Bt + (size_t)(n0 + fr) * K + kb; const bf16* ap = A + (size_t)(ROW_META + fr) * lda + kb;
    f32x4 acc[9];
#pragma unroll
    for (int m = 0; m < 9; ++m) acc[m] = (f32x4){0.f, 0.f, 0.f, 0.f};
#pragma unroll 2
    for (int ks = 0; ks < KSTEPS; ++ks) {
        const bf16x8 fb = *(const bf16x8*)(bp + 32 * ks); bf16x8 fa[9];
#pragma unroll
        for (int m = 0; m < 9; ++m) fa[m] = *(const bf16x8*)(ap + (size_t)(16 * m) * lda + 32 * ks);
#pragma unroll
        for (int m = 0; m < 9; ++m) acc[m] = __builtin_amdgcn_mfma_f32_16x16x32_bf16(fb, fa[m], acc[m], 0, 0, 0);
    }
    LAS f32x4* red = (LAS f32x4*)lds;
#pragma unroll
    for (int m = 0; m < 9; ++m) red[(wave * 9 + m) * 64 + lane] = acc[m];
    __syncthreads();
    r0 = (f32x4){0.f, 0.f, 0.f, 0.f}; r1 = r0;
#pragma unroll
    for (int w = 0; w < 8; ++w) r0 += red[(w * 9 + wave) * 64 + lane];
    if (wave == 0) {
#pragma unroll
        for (int w = 0; w < 8; ++w) r1 += red[(w * 9 + 8) * 64 + lane]; }
    __syncthreads();
}
__device__ __forceinline__ v2u pack4(const f32x4 v) { return (v2u){pk2(v[0], v[1]), pk2(v[2], v[3])}; }
__device__ __forceinline__ void skinny_in(const Args& a, LAS unsigned char* lds, int u, int lane, int wave) {
    unsigned char* ws = a.ws; const bf16* XB = (const bf16*)(ws + WS_XB); const bf16* W = (const bf16*)(ws + WS_WIN); const float* RS1 = (const float*)(ws + OFF_RS1);
    const int fr = lane & 15, fq = lane >> 4;
    if (u < 128) {
        const int n0 = 16 * u, type = n0 >> 9, cw = (n0 & 511) + 4 * fq;
        f32x4 r[2]; skinny_slab<4>(XB, D, W, n0, lds, wave, lane, r[0], r[1]);
        f32x4 lb = {0.f, 0.f, 0.f, 0.f}; if (type == 1) lb = *(const f32x4*)((const float*)(ws + OFF_LB) + cw);
#pragma unroll
        for (int x = 0; x < 2; ++x) { if (x == 1 && wave != 0) break; const int row = ROW_META + 16 * (x ? 8 : wave) + fr; const float rs = RS1[row]; f32x4 v = r[x] * rs; const size_t off = (size_t)row * 512 + cw;
            if (type == 1) {
#pragma unroll
                for (int i = 0; i < 4; ++i) v[i] = __logf(lb[i] + (1.0f - lb[i]) * pg8::sigm(v[i]));
                *(f32x4*)((float*)(ws + WS_LF) + off) = v;
            } else {
                if (type != 2) {
#pragma unroll
                    for (int i = 0; i < 4; ++i) v[i] = pg8::silu_f(v[i]); }
                const int sel = (type == 0) ? 0 : (type == 2 ? 1 : 3);
                *(v2u*)((bf16*)(ws + WS_Q) + (size_t)sel * ((size_t)MROWS * 512) + off) = pack4(v); } }
    } else {
        const int p = u - 128, j = p >> 3, s = p & 7, n0 = 2048 + 256 * j + 16 * s;
        f32x4 ra[2], rb[2]; skinny_slab<4>(XB, D, W, n0, lds, wave, lane, ra[0], ra[1]); skinny_slab<4>(XB, D, W, n0 + 128, lds, wave, lane, rb[0], rb[1]);
#pragma unroll
        for (int x = 0; x < 2; ++x) { if (x == 1 && wave != 0) break; const int row = ROW_META + 16 * (x ? 8 : wave) + fr; const float rs = RS1[row]; f32x4 g;
#pragma unroll
            for (int i = 0; i < 4; ++i) g[i] = ra[x][i] * rs * pg8::sigm(rb[x][i] * rs);
            *(v2u*)((bf16*)(ws + WS_GLU) + (size_t)row * 512 + 128 * j + 16 * s + 4 * fq) = pack4(g); }
    }
}
__device__ __forceinline__ void skinny_out(const Args& a, LAS unsigned char* lds, int u, int lane, int wave) {
    unsigned char* ws = a.ws; const int fr = lane & 15, fq = lane >> 4, n0 = 16 * u;
    f32x4 r[2]; skinny_slab<4>((const bf16*)(ws + WS_YM), D, (const bf16*)(ws + WS_WOUT), n0, lds, wave, lane, r[0], r[1]);
#pragma unroll
    for (int x = 0; x < 2; ++x) { if (x == 1 && wave != 0) break; const int row = ROW_META + 16 * (x ? 8 : wave) + fr; const float* rp = pg8::resid_row(a.x_prompt, a.meta, a.x_sample, row);
        const f32x4 v = r[x] + *(const f32x4*)(rp + n0 + 4 * fq); const size_t off = (size_t)row * D + n0 + 4 * fq;
        *(f32x4*)((float*)(ws + WS_H1) + off) = v; *(v2u*)((bf16*)(ws + WS_HB) + off) = pack4(v);
        float ss = (v[0] * v[0] + v[1] * v[1]) + (v[2] * v[2] + v[3] * v[3]); ss += __shfl_xor(ss, 16); ss += __shfl_xor(ss, 32);
        if (fq == 0) atomicAdd((float*)(ws + OFF_SS2) + row, ss); }
}
__device__ __forceinline__ void skinny_up(const Args& a, LAS unsigned char* lds, int u, int lane, int wave) {
    unsigned char* ws = a.ws; const int fr = lane & 15, fq = lane >> 4, n0 = 16 * u;
    f32x4 r[2]; skinny_slab<4>((const bf16*)(ws + WS_HB), D, (const bf16*)(ws + WS_WUP), n0, lds, wave, lane, r[0], r[1]);
#pragma unroll
    for (int x = 0; x < 2; ++x) { if (x == 1 && wave != 0) break; const int row = ROW_META + 16 * (x ? 8 : wave) + fr; const float rs = __builtin_amdgcn_rsqf(((const float*)(ws + OFF_SS2))[row] * (1.0f / D) + EPS);
        f32x4 v = r[x] * rs;
#pragma unroll
        for (int i = 0; i < 4; ++i) { const float t = fmaxf(v[i], 0.f); v[i] = t * t; }
        *(v2u*)((bf16*)(ws + WS_HID) + (size_t)row * FF + n0 + 4 * fq) = pack4(v); }
}
__device__ __forceinline__ void skinny_down(const Args& a, LAS unsigned char* lds, int u, int lane, int wave) {
    unsigned char* ws = a.ws; const int fr = lane & 15, fq = lane >> 4, n0 = 16 * u;
    f32x4 r[2]; skinny_slab<16>((const bf16*)(ws + WS_HID), FF, (const bf16*)(ws + WS_WDN), n0, lds, wave, lane, r[0], r[1]);
#pragma unroll
    for (int x = 0; x < 2; ++x) { if (x == 1 && wave != 0) break; const int row = ROW_META + 16 * (x ? 8 : wave) + fr;
        if (row >= ROW_SAMP) { const f32x4 v = r[x] + *(const f32x4*)((const float*)(ws + WS_H1) + (size_t)row * D + n0 + 4 * fq);
            *(f32x4*)(a.out + O_YS + (size_t)(row - ROW_SAMP) * D + n0 + 4 * fq) = v;
            float ss = (v[0] * v[0] + v[1] * v[1]) + (v[2] * v[2] + v[3] * v[3]); ss += __shfl_xor(ss, 16); ss += __shfl_xor(ss, 32);
            if (fq == 0) atomicAdd((float*)(ws + OFF_SS3) + row, ss); } }
}

constexpr int L_QD = 0, L_KI = 17408, L_KIT = 34816, L_VT = 53248, L_SC = 71680, L_PART = 80896, L_DEC = 82944;
__device__ __forceinline__ bf16x8 lds_frag(LAS unsigned char* base, int row, int stride_b, int kbyte) { return *(const LAS bf16x8*)(base + row * stride_b + kbyte); }
__device__ __forceinline__ void hgrn_chunk_item(const Args& a, LAS unsigned char* lds, int item, int tid, int lane, int wave) {
    unsigned char* ws = a.ws;
    const bool meta = item >= 1024; const int h = meta ? item - 1024 : (item & 3), bn = meta ? 0 : (item >> 2);
    const float* LF = (const float*)(ws + WS_LF); const bf16* Q = (const bf16*)(ws + WS_Q); const bf16* V = (const bf16*)(ws + WS_V);
    bf16* QDg = (bf16*)(ws + WS_QD); bf16* OI = (bf16*)(ws + WS_OI); float* DEC = (float*)(ws + WS_DEC);
    float* DSo = meta ? (float*)(ws + OFF_DSM) + (size_t)h * 16384 : (float*)(ws + WS_DS) + ((size_t)bn * 4 + h) * 16384;
    const int d = tid & 127, tq = tid >> 7; const bool valid = !meta || tq == 3;
    const int rbase = meta ? ROW_META : bn * 64 + 16 * tq;
    const size_t cbase = (size_t)rbase * 512 + h * 128 + d;
    LAS float* PART = (LAS float*)(lds + L_PART); LAS float* DECl = (LAS float*)(lds + L_DEC);
    float c[16];
    { float run = 0.f;
#pragma unroll
      for (int i = 0; i < 16; ++i) { const float lf = valid ? LF[cbase + (size_t)i * 512] : 0.f; run += lf; c[i] = run; }
      PART[tq * 128 + d] = run; }
    __syncthreads();
    float off = 0.f, bend = 0.f;
#pragma unroll
    for (int j = 0; j < 4; ++j) { const float pj = PART[j * 128 + d]; bend += pj; if (j < tq) off += pj; }
    unsigned kit[8], vt[8];
    float prev = 0.f;
#pragma unroll
    for (int i = 0; i < 16; ++i) {
        const float bcur = off + c[i], lf = c[i] - prev; prev = c[i];
        const float e = __expf(bcur), einv = __expf(-bcur);
        float q = 0.f, k = 0.f, v = 0.f;
        if (valid) { q = bf2f(Q[cbase + (size_t)i * 512]); v = bf2f(V[cbase + (size_t)i * 512]); k = 1.0f - __expf(lf); }
        const unsigned qd = f2bf(q * e), ki = f2bf(k * einv), vb = f2bf(v);
        const int t = 16 * tq + i;
        *(LAS unsigned short*)(lds + L_QD + t * 272 + d * 2) = (unsigned short)qd;
        *(LAS unsigned short*)(lds + L_KI + t * 272 + d * 2) = (unsigned short)ki;
        if (!meta) QDg[cbase + (size_t)i * 512] = (unsigned short)qd;
        if (i & 1) { kit[i >> 1] |= ki << 16; vt[i >> 1] |= vb << 16; } else { kit[i >> 1] = ki; vt[i >> 1] = vb; }
    }
    { LAS v4u* pk = (LAS v4u*)(lds + L_KIT + d * 144 + tq * 32); pk[0] = (v4u){kit[0], kit[1], kit[2], kit[3]}; pk[1] = (v4u){kit[4], kit[5], kit[6], kit[7]};
      LAS v4u* pv = (LAS v4u*)(lds + L_VT + d * 144 + tq * 32); pv[0] = (v4u){vt[0], vt[1], vt[2], vt[3]}; pv[1] = (v4u){vt[4], vt[5], vt[6], vt[7]}; }
    if (tq == 0) { const float dc = __expf(bend); DECl[d] = dc; if (!meta) DEC[(size_t)bn * 512 + h * 128 + d] = dc; }
    __syncthreads();
    const int fr = lane & 15, fq = lane >> 4;
    if (!meta) {
#pragma unroll
        for (int x = 0; x < 2; ++x) { const int idx = wave * 2 + x, tt = idx >> 2, st = idx & 3;
            f32x4 acc = {0.f, 0.f, 0.f, 0.f};
            if (st <= tt) {
#pragma unroll
                for (int ks = 0; ks < 4; ++ks) { const bf16x8 fa = lds_frag(lds + L_KI, 16 * st + fr, 272, 64 * ks + 16 * fq), fb = lds_frag(lds + L_QD, 16 * tt + fr, 272, 64 * ks + 16 * fq);
                    acc = __builtin_amdgcn_mfma_f32_16x16x32_bf16(fa, fb, acc, 0, 0, 0); }
                const int t = 16 * tt + fr, s0 = 16 * st + 4 * fq;
#pragma unroll
                for (int r = 0; r < 4; ++r) if (s0 + r > t) acc[r] = 0.f;
            }
            *(LAS v2u*)(lds + L_SC + (16 * tt + fr) * 144 + (16 * st + 4 * fq) * 2) = (v2u){pk2(acc[0], acc[1]), pk2(acc[2], acc[3])}; }
    }
    __syncthreads();
    const int vt_i = wave;
    const bf16x8 fv0 = lds_frag(lds + L_VT, 16 * vt_i + fr, 144, 16 * fq), fv1 = lds_frag(lds + L_VT, 16 * vt_i + fr, 144, 64 + 16 * fq);
    if (!meta) {
#pragma unroll
        for (int tt = 0; tt < 4; ++tt) { f32x4 acc = {0.f, 0.f, 0.f, 0.f};
            const bf16x8 s0 = lds_frag(lds + L_SC, 16 * tt + fr, 144, 16 * fq), s1 = lds_frag(lds + L_SC, 16 * tt + fr, 144, 64 + 16 * fq);
            acc = __builtin_amdgcn_mfma_f32_16x16x32_bf16(fv0, s0, acc, 0, 0, 0); acc = __builtin_amdgcn_mfma_f32_16x16x32_bf16(fv1, s1, acc, 0, 0, 0);
            *(v2u*)(OI + (size_t)(bn * 64 + 16 * tt + fr) * 512 + h * 128 + 16 * vt_i + 4 * fq) = (v2u){pk2(acc[0], acc[1]), pk2(acc[2], acc[3])}; }
    }
#pragma unroll
    for (int dt = 0; dt < 8; ++dt) { f32x4 acc = {0.f, 0.f, 0.f, 0.f};
        const bf16x8 k0 = lds_frag(lds + L_KIT, 16 * dt + fr, 144, 16 * fq), k1 = lds_frag(lds + L_KIT, 16 * dt + fr, 144, 64 + 16 * fq);
        acc = __builtin_amdgcn_mfma_f32_16x16x32_bf16(k0, fv0, acc, 0, 0, 0); acc = __builtin_amdgcn_mfma_f32_16x16x32_bf16(k1, fv1, acc, 0, 0, 0);
        const f32x4 dc = *(const LAS f32x4*)(DECl + 16 * dt + 4 * fq);
        *(f32x4*)(DSo + (size_t)(16 * vt_i + fr) * 128 + 16 * dt + 4 * fq) = acc * dc; }
    __syncthreads();
}

__device__ __forceinline__ void conv_item(const Args& a, LAS unsigned char* lds, int item, int tid, int lane, int wave) {
    unsigned char* ws = a.ws; const bf16* GLU = (const bf16*)(ws + WS_GLU); bf16* YM = (bf16*)(ws + WS_YM);
    const int b = item >> 5, g = item & 31, c = tid; const int r0 = b * SEQ + g * 64;
    float w[31];
#pragma unroll
    for (int j = 0; j < 31; ++j) w[j] = a.conv_w[j * 512 + c];
    const float bias = a.conv_b[c];
    LAS float* DW = (LAS float*)lds;
    LAS unsigned short* GW = (LAS unsigned short*)(lds + 65536);
    float lg[8], lb[8];
#pragma unroll
    for (int i = 0; i < 8; ++i) { lg[i] = a.conv_ln_g[8 * lane + i]; lb[i] = a.conv_ln_b[8 * lane + i]; }
    for (int grp = 0; grp < 2; ++grp) {
        const int rg = r0 + 32 * grp;
#pragma unroll
        for (int k = 0; k < 8; ++k) { const int q = tid + 512 * k; const int rr = q >> 6, cc = (q & 63) * 8;
            if (rr < 62) { const int tp = g * 64 + 32 * grp + rr - 30; v4u x = {0u, 0u, 0u, 0u};
                if (tp >= 0) x = *(const v4u*)(GLU + (size_t)(b * SEQ + tp) * 512 + cc); else if (tp >= -16) x = *(const v4u*)(GLU + (size_t)(ROW_META + 16 + tp) * 512 + cc);
                *(LAS v4u*)(GW + rr * 512 + cc) = x; } }
        __syncthreads();
        if (g == 31 && grp == 1) {
#pragma unroll 1
            for (int i = 2; i < 32; ++i) a.out[O_SCP + (size_t)(b * 30 + i - 2) * 512 + c] = bf2f(GW[(30 + i) * 512 + c]); }
#pragma unroll 1
        for (int ib = 0; ib < 4; ++ib) {
            const LAS unsigned short* gp = GW + ib * 8 * 512 + c; LAS float* dp = DW + ib * 8 * 512 + c;
            float xv[38];
#pragma unroll
            for (int i = 0; i < 38; ++i) xv[i] = bf2f(gp[i * 512]);
#pragma unroll
            for (int i = 0; i < 8; ++i) {
                float acc = bias;
#pragma unroll
                for (int j = 0; j < 31; ++j) acc += w[j] * xv[i + j];
                dp[i * 512] = acc;
            }
        }
        __syncthreads();
#pragma unroll
        for (int rr = 0; rr < 4; ++rr) { const int i = wave + 8 * rr;
            const f32x4 x0 = *(const LAS f32x4*)(DW + i * 512 + 8 * lane), x1 = *(const LAS f32x4*)(DW + i * 512 + 8 * lane + 4);
            const float mean = wave_sum((x0[0] + x0[1]) + (x0[2] + x0[3]) + (x1[0] + x1[1]) + (x1[2] + x1[3])) * (1.0f / 512.0f);
            const f32x4 d0 = x0 - mean, d1 = x1 - mean;
            const float var = wave_sum((d0[0] * d0[0] + d0[1] * d0[1]) + (d0[2] * d0[2] + d0[3] * d0[3]) + (d1[0] * d1[0] + d1[1] * d1[1]) + (d1[2] * d1[2] + d1[3] * d1[3])) * (1.0f / 512.0f);
            const float rstd = __builtin_amdgcn_rsqf(var + EPS);
            float y[8];
#pragma unroll
            for (int k = 0; k < 4; ++k) { y[k] = pg8::silu_f(d0[k] * rstd * lg[k] + lb[k]); y[4 + k] = pg8::silu_f(d1[k] * rstd * lg[4 + k] + lb[4 + k]); }
            *(v4u*)(YM + (size_t)(rg + i) * 1024 + 512 + 8 * lane) = (v4u){pk2(y[0], y[1]), pk2(y[2], y[3]), pk2(y[4], y[5]), pk2(y[6], y[7])}; }
        __syncthreads();
    }
}

__device__ __forceinline__ void sample_item(const Args& a, LAS unsigned char* lds, int s, int tid, int lane, int wave) {
    unsigned char* ws = a.ws; const int row = ROW_SAMP + s;
    const bf16* GLU = (const bf16*)(ws + WS_GLU); bf16* YM = (bf16*)(ws + WS_YM);
    const float* LF = (const float*)(ws + WS_LF); const bf16* Q = (const bf16*)(ws + WS_Q); const bf16* V = (const bf16*)(ws + WS_V); const bf16* G = (const bf16*)(ws + WS_G);
    LAS float* RED = (LAS float*)lds;
    LAS float* OP = (LAS float*)(lds + 1024);
    {
        const int c = tid; const float* sc = a.state_conv + (size_t)s * 30 * 512 + c; float* so = a.out + O_SCS + (size_t)s * 30 * 512 + c;
        const float glu = bf2f(GLU[(size_t)row * 512 + c]);
        float acc = a.conv_b[c];
#pragma unroll
        for (int j = 0; j < 30; ++j) { const float x = sc[j * 512]; acc += a.conv_w[j * 512 + c] * x; if (j >= 1) so[(j - 1) * 512] = x; }
        acc += a.conv_w[30 * 512 + c] * glu; so[29 * 512] = glu;
        float sm = wave_sum(acc); if (lane == 0) RED[wave] = sm;
        __syncthreads();
        float mean = 0.f;
#pragma unroll
        for (int j = 0; j < 8; ++j) mean += RED[j];
        mean *= (1.0f / 512.0f);
        const float dd = acc - mean; float sv = wave_sum(dd * dd); if (lane == 0) RED[8 + wave] = sv;
        __syncthreads();
        float var = 0.f;
#pragma unroll
        for (int j = 0; j < 8; ++j) var += RED[8 + j];
        const float rstd = __builtin_amdgcn_rsqf(var * (1.0f / 512.0f) + EPS);
        const float y = pg8::silu_f(dd * rstd * a.conv_ln_g[c] + a.conv_ln_b[c]);
        YM[(size_t)row * 1024 + 512 + c] = (unsigned short)f2bf(y);
    }
    const int vq = tid & 31, dg = tid >> 5;
    for (int h = 0; h < 4; ++h) {
        const size_t hb = (size_t)row * 512 + h * 128;
        const v2u vv = *(const v2u*)(V + hb + 4 * vq); const f32x4 v4 = {bflo(vv.x), bfhi(vv.x), bflo(vv.y), bfhi(vv.y)};
        const float* Sin = a.state_hgrn + ((size_t)(s * 4 + h) * 128) * 128 + 4 * vq; float* Sout = a.out + O_SHS + ((size_t)(s * 4 + h) * 128) * 128 + 4 * vq;
        f32x4 o4 = {0.f, 0.f, 0.f, 0.f};
#pragma unroll
        for (int dd = 0; dd < 8; ++dd) { const int d = 8 * dg + dd; const float f = __expf(LF[hb + d]), k = 1.0f - f, q = bf2f(Q[hb + d]);
            f32x4 S = *(const f32x4*)(Sin + (size_t)d * 128); S = S * f + v4 * k; *(f32x4*)(Sout + (size_t)d * 128) = S; o4 += S * q; }
        __syncthreads();
        *(LAS f32x4*)(OP + dg * 128 + 4 * vq) = o4;
        __syncthreads();
        if (wave == 0) { float oa = 0.f, ob = 0.f;
#pragma unroll
            for (int j = 0; j < 16; ++j) { oa += OP[j * 128 + lane]; ob += OP[j * 128 + 64 + lane]; }
            const float rstd = __builtin_amdgcn_rsqf(wave_sum(oa * oa + ob * ob) * (1.0f / 128.0f) + EPS);
            const float ya = oa * rstd * a.hg_onorm_g[lane] * bf2f(G[hb + lane]), yb = ob * rstd * a.hg_onorm_g[64 + lane] * bf2f(G[hb + 64 + lane]);
            YM[(size_t)row * 1024 + h * 128 + lane] = (unsigned short)f2bf(ya); YM[(size_t)row * 1024 + h * 128 + 64 + lane] = (unsigned short)f2bf(yb); }
    }
    __syncthreads();
}

__device__ __forceinline__ void scan_phase(const Args& a, int tid) {
    unsigned char* ws = a.ws; const float* DS = (const float*)(ws + WS_DS); const float* DSM = (const float*)(ws + OFF_DSM); const float* DEC = (const float*)(ws + WS_DEC); bf16* SST = (bf16*)(ws + WS_SST);
    for (int e = blockIdx.x * NTHR + tid; e < NB * 4 * 128 * 32; e += gridDim.x * NTHR) {
        const int d4 = (e & 31) * 4, v = (e >> 5) & 127, h = (e >> 12) & 3, b = e >> 14;
        f32x4 S = *(const f32x4*)(DSM + (size_t)h * 16384 + v * 128 + d4);
#pragma unroll 4
        for (int n = 0; n < NCH; ++n) { const size_t it = ((size_t)(b * 32 + n) * 4 + h) * 16384 + v * 128 + d4;
            const f32x4 ds = *(const f32x4*)(DS + it), dc = *(const f32x4*)(DEC + (size_t)(b * 32 + n) * 512 + h * 128 + d4);
            *(v2u*)(SST + it) = (v2u){pk2(S[0], S[1]), pk2(S[2], S[3])};
            S = S * dc + ds; }
        float* so = a.out + O_SHP + ((size_t)(b * 4 + h) * 128 + d4) * 128 + v;
        so[0] = S[0]; so[128] = S[1]; so[256] = S[2]; so[384] = S[3];
    }
}

__device__ __forceinline__ void ointer_item(const Args& a, int item, int lane, int wave) {
    unsigned char* ws = a.ws; const bf16* QD = (const bf16*)(ws + WS_QD); const bf16* SST = (const bf16*)(ws + WS_SST); const bf16* OI = (const bf16*)(ws + WS_OI); const bf16* G = (const bf16*)(ws + WS_G); bf16* YM = (bf16*)(ws + WS_YM);
    const int bn = item >> 1, h = (item & 1) * 2 + (wave >> 2), tt = wave & 3, fr = lane & 15, fq = lane >> 4;
    const int row = bn * 64 + 16 * tt + fr; const size_t hb = (size_t)row * 512 + h * 128;
    bf16x8 fb[4];
#pragma unroll
    for (int ks = 0; ks < 4; ++ks) fb[ks] = *(const bf16x8*)(QD + hb + 32 * ks + 8 * fq);
    const bf16* Sb = SST + ((size_t)bn * 4 + h) * 16384;
    f32x4 o[8]; float ss = 0.f;
#pragma unroll
    for (int vt = 0; vt < 8; ++vt) { f32x4 acc = {0.f, 0.f, 0.f, 0.f};
#pragma unroll
        for (int ks = 0; ks < 4; ++ks) { const bf16x8 fa = *(const bf16x8*)(Sb + (size_t)(16 * vt + fr) * 128 + 32 * ks + 8 * fq); acc = __builtin_amdgcn_mfma_f32_16x16x32_bf16(fa, fb[ks], acc, 0, 0, 0); }
        const v2u oi = *(const v2u*)(OI + hb + 16 * vt + 4 * fq);
        acc[0] += bflo(oi.x); acc[1] += bfhi(oi.x); acc[2] += bflo(oi.y); acc[3] += bfhi(oi.y);
        ss += (acc[0] * acc[0] + acc[1] * acc[1]) + (acc[2] * acc[2] + acc[3] * acc[3]); o[vt] = acc; }
    ss += __shfl_xor(ss, 16); ss += __shfl_xor(ss, 32);
    const float rstd = __builtin_amdgcn_rsqf(ss * (1.0f / 128.0f) + EPS);
#pragma unroll
    for (int vt = 0; vt < 8; ++vt) { const v2u gg = *(const v2u*)(G + hb + 16 * vt + 4 * fq); const f32x4 og = *(const f32x4*)(a.hg_onorm_g + 16 * vt + 4 * fq);
        const float y0 = o[vt][0] * rstd * og[0] * bflo(gg.x), y1 = o[vt][1] * rstd * og[1] * bfhi(gg.x), y2 = o[vt][2] * rstd * og[2] * bflo(gg.y), y3 = o[vt][3] * rstd * og[3] * bfhi(gg.y);
        *(v2u*)(YM + (size_t)row * 1024 + h * 128 + 16 * vt + 4 * fq) = (v2u){pk2(y0, y1), pk2(y2, y3)}; }
}

__device__ __forceinline__ void final_norm(const Args& a, int lane, int wave) {
    const float* SS3 = (const float*)(a.ws + OFF_SS3);
    f32x4 g[4];
#pragma unroll
    for (int j = 0; j < 4; ++j) g[j] = ((const f32x4*)a.final_g)[lane + 64 * j];
    for (int m = blockIdx.x * NWAVES + wave; m < ROWS_REAL + NSAMP; m += gridDim.x * NWAVES) {
        const int row = m < ROWS_REAL ? m : ROW_SAMP + (m - ROWS_REAL);
        f32x4* p = (f32x4*)(a.out + (size_t)m * D) + lane;
        const float rs = __builtin_amdgcn_rsqf(SS3[row] * (1.0f / D) + EPS);
#pragma unroll
        for (int j = 0; j < 4; ++j) p[64 * j] = p[64 * j] * rs * g[j];
    }
}

__global__ void __launch_bounds__(NTHR, 2) hymba_fwd(Args args) {
    extern __shared__ __attribute__((aligned(16))) unsigned char lds_raw[];
    LAS unsigned char* lds = (LAS unsigned char*)lds_raw;
    const int tid = threadIdx.x, lane = tid & 63, wave = __builtin_amdgcn_readfirstlane(tid >> 6);
    const int G = gridDim.x, bx = blockIdx.x;
    unsigned char* ws = args.ws;
    const int lo = args.ph_lo, hi = args.ph_hi;
#ifndef PHMASK
#define PHMASK 0x1ff
#endif
#define IN(k) (((PHMASK >> (k)) & 1) && lo <= (k) && (k) < hi)
#define SEAM(k) do { if (IN(k) && IN((k) + 1)) { cg::this_grid().sync(); } } while (0)
    if (IN(0)) { p0_prologue(args, lds, tid, lane, wave); }
    SEAM(0);
    if (IN(1)) {
        pg8::Gemm g{(const pg8::bf16_t*)(ws + WS_XB), (const pg8::bf16_t*)(ws + WS_WIN), MROWS, NIN, D}; pg8::StaticOrder S; S.init(ROWS_REAL, NIN, G, bx);
        pg8::EpiIn E{(bf16*)(ws + WS_Q), (bf16*)(ws + WS_V), (bf16*)(ws + WS_G), (bf16*)(ws + WS_GLU), (float*)(ws + WS_LF), (const float*)(ws + OFF_RS1), (const float*)(ws + OFF_LB)};
        pg8::gemm_phase<pg8::EpiIn, pg8::StaticOrder, true, true>(lds, g, S, E);
        for (int u = bx; u < 160; u += G) skinny_in(args, lds, u, lane, wave);
    }
    SEAM(1);
    if (IN(2)) {
#ifndef P2SEL
#define P2SEL 7
#endif
        if (P2SEL & 1) for (int it = bx; it < 1028; it += G) hgrn_chunk_item(args, lds, it, tid, lane, wave);
        if ((P2SEL & 2) && bx < 256) conv_item(args, lds, bx, tid, lane, wave);
        if (P2SEL & 4) for (int it = bx; it < NSAMP; it += G) sample_item(args, lds, it, tid, lane, wave);
    }
    SEAM(2);
    if (IN(3)) { scan_phase(args, tid); }
    SEAM(3);
    if (IN(4)) { for (int it = bx; it < NB * NCH * 2; it += G) ointer_item(args, it, lane, wave); }
    SEAM(4);
    if (IN(5)) {
        pg8::Gemm g{(const pg8::bf16_t*)(ws + WS_YM), (const pg8::bf16_t*)(ws + WS_WOUT), MROWS, D, D}; pg8::StaticOrder S; S.init(ROWS_REAL, D, G, bx);
        pg8::EpiOut E{args.x_prompt, args.meta, args.x_sample, (float*)(ws + WS_H1), (bf16*)(ws + WS_HB), (float*)(ws + OFF_SS2)};
        pg8::gemm_phase<pg8::EpiOut, pg8::StaticOrder, true, true>(lds, g, S, E);
        for (int u = bx; u < 64; u += G) skinny_out(args, lds, u, lane, wave);
    }
    SEAM(5);
    if (IN(6)) {
        pg8::Gemm g{(const pg8::bf16_t*)(ws + WS_HB), (const pg8::bf16_t*)(ws + WS_WUP), MROWS, FF, D}; pg8::StaticOrder S; S.init(ROWS_REAL, FF, G, bx);
        pg8::EpiUp E{(bf16*)(ws + WS_HID), (const float*)(ws + OFF_SS2)};
        pg8::gemm_phase<pg8::EpiUp, pg8::StaticOrder, true, true>(lds, g, S, E);
        for (int u = bx; u < 256; u += G) skinny_up(args, lds, u, lane, wave);
    }
    SEAM(6);
    if (IN(7)) {
        pg8::Gemm g{(const pg8::bf16_t*)(ws + WS_HID), (const pg8::bf16_t*)(ws + WS_WDN), MROWS, D, FF}; pg8::StaticOrder S; S.init(ROWS_REAL, D, G, bx);
        pg8::EpiDown E{(const float*)(ws + WS_H1), args.out + O_YP, args.out + O_YS, (float*)(ws + OFF_SS3)};
        pg8::gemm_phase<pg8::EpiDown, pg8::StaticOrder, true, true>(lds, g, S, E);
        for (int u = bx; u < 64; u += G) skinny_down(args, lds, u, lane, wave);
    }
    SEAM(7);
    if (IN(8)) { final_norm(args, lane, wave); }
#undef IN
#undef SEAM
}

#ifndef N_LAUNCH_MODE
#define N_LAUNCH_MODE 1
#endif
extern "C" void kernel_launch(void* const* d_in, const int* in_sizes, int n_in, void* d_out, int out_size, void* d_ws, size_t ws_size, hipStream_t stream) {
    static int grid = 0;
    if (grid == 0) {
        int dev = 0, cus = 0, per_cu = 0;
        hipGetDevice(&dev); hipDeviceGetAttribute(&cus, hipDeviceAttributeMultiprocessorCount, dev);
        hipFuncSetAttribute((const void*)hymba_fwd, hipFuncAttributeMaxDynamicSharedMemorySize, LDS_BYTES);
        hipOccupancyMaxActiveBlocksPerMultiprocessor(&per_cu, (const void*)hymba_fwd, NTHR, LDS_BYTES);
        if (per_cu < 1) per_cu = 1;
        grid = cus * per_cu;
        if (ws_size < WS_END || n_in != 18) { fprintf(stderr, "kernel_launch: ws %zu < %zu or n_in %d\n", ws_size, (size_t)WS_END, n_in); }
        fprintf(stderr, "kernel_launch: grid %d (cus %d x %d)\n", grid, cus, per_cu);
    }
    Args a{};
    const float** pp = (const float**)&a;
    for (int i = 0; i < 18; ++i) pp[i] = (const float*)d_in[i];
    a.out = (float*)d_out; a.ws = (unsigned char*)d_ws; a.pad = 0;
#if N_LAUNCH_MODE == 1
    a.ph_lo = 0; a.ph_hi = 9; a.coop = 1;
    void* kargs[] = {&a};
    hipError_t e = hipLaunchCooperativeKernel((const void*)hymba_fwd, dim3(grid), dim3(NTHR), kargs, LDS_BYTES, stream);
    if (e != hipSuccess) fprintf(stderr, "cooperative launch failed: %s (grid %d)\n", hipGetErrorString(e), grid);
#else
#ifndef DUP_MASK
#define DUP_MASK 0
#endif
    for (int p = 0; p < 9; ++p) for (int r = 0; r < 1 + ((DUP_MASK >> p) & 1); ++r) { a.ph_lo = p; a.ph_hi = p + 1; a.coop = 0; hipLaunchKernelGGL(hymba_fwd, dim3(grid), dim3(NTHR), LDS_BYTES, stream, a); }
#endif
}
```

```cpp
#include <hip/hip_runtime.h>
#include <hip/hip_cooperative_groups.h>
#include <cstdio>
#include <cstdint>
namespace cg = cooperative_groups;
namespace pg8 {
#define PG8_LAS __attribute__((address_space(3)))
typedef unsigned short bf16_t;
typedef short bf16x8 __attribute__((ext_vector_type(8)));
typedef float f32x4 __attribute__((ext_vector_type(4)));
typedef unsigned u32x4 __attribute__((ext_vector_type(4)));
constexpr int BM = 256, BK = 64, HALF = 128, HTB = HALF * BK * 2  , STAGE_BYTES = 8 * HTB, NXCD = 8, WGM = 8;

__host__ __device__ __forceinline__ int lds_byte(int r, int c) { const int st = (r >> 4) * 2 + (c >> 5), rr = r & 15, cc = c & 31, ob = rr * 64 + cc * 2; return st * 1024 + (ob ^ (((ob >> 9) & 1) << 5)); }
__host__ __device__ __forceinline__ void stage_rc(int b, int& R, int& C) { const int st = b / 1024, sb = b % 1024, swz = sb ^ (((sb >> 9) & 1) << 5); R = (st >> 1) * 16 + swz / 64; C = (st & 1) * 32 + (swz % 64) / 2; }
__host__ __device__ __forceinline__ int perm32(int rho) { const int n = rho >> 4, i = rho & 15; return 8 * (i >> 2) + 4 * n + (i & 3); }

struct Unit { int pm, pn; };
struct Gemm { const bf16_t* A; const bf16_t* Bt; int M, N, K; };

struct StaticOrder {
    int nM, nN, nwg, G, c;
    __host__ __device__ void init(int M, int N, int G_, int c_) { nM = M / BM; nN = N / BM; nwg = nM * nN; G = G_; c = c_; }
    __host__ __device__ bool next(int i, Unit& u) const {
        const long L = (long)i * G + c; if (L >= nwg) return false;
        int wgid = (int)L; { const int q = nwg / NXCD, r = nwg % NXCD, xcd = wgid % NXCD, off = wgid / NXCD; wgid = (xcd < r ? xcd * (q + 1) : r * (q + 1) + (xcd - r) * q) + off; }
        const int nig = WGM * nN, gid = wgid / nig, fm = gid * WGM, gsz = (nM - fm) < WGM ? (nM - fm) : WGM;
        u.pm = fm + ((wgid % nig) % gsz); u.pn = (wgid % nig) / gsz; return true;
    }
    __device__ __forceinline__ void a_ready(const Unit&) const {}
    __device__ __forceinline__ void done(const Unit&) const {}
};

typedef __bf16 hw_bf16x2 __attribute__((ext_vector_type(2)));
typedef float hw_f32x2 __attribute__((ext_vector_type(2)));
__device__ __forceinline__ unsigned cvt_pk_bf16(float lo, float hi) { const hw_f32x2 v = {lo, hi}; return __builtin_bit_cast(unsigned, __builtin_convertvector(v, hw_bf16x2)); }
typedef float f32x2 __attribute__((ext_vector_type(2)));
constexpr int ROWS_REAL = 16384, ROW_META = 16384, ROW_SAMP = 16400, ROWS_USED = 16528, MROWS = 16640;
__device__ __forceinline__ float sigm(float x) { return __builtin_amdgcn_rcpf(1.0f + __expf(-x)); }
__device__ __forceinline__ float silu_f(float x) { return x * sigm(x); }
__device__ __forceinline__ u32x4 pack8(const f32x4 a, const f32x4 b) { u32x4 w; w.x = cvt_pk_bf16(a[0], a[1]); w.y = cvt_pk_bf16(a[2], a[3]); w.z = cvt_pk_bf16(b[0], b[1]); w.w = cvt_pk_bf16(b[2], b[3]); return w; }

struct EpiIn {
    static constexpr bool PERM = true, AFTER_DRAIN = false;
    bf16_t *Q, *V, *G, *GLU; float* LF; const float* rs1; const float* LB;
    __device__ __forceinline__ void operator()(const f32x4 (&acc)[2][2][4][2], const Unit& u, int wr, int wc, int fr, int fq) const {
        const int row0 = u.pm * BM + wr * 64 + fr; const int pn = u.pn;
        float rsv[2][4];
#pragma unroll
        for (int ai = 0; ai < 2; ++ai)
#pragma unroll
            for (int m = 0; m < 4; ++m) rsv[ai][m] = rs1[row0 + ai * HALF + m * 16];
        if (pn < 8) {
            const int type = pn >> 1; const int colb = (pn & 1) * 256 + wc * 32 + 8 * fq;
            f32x4 lb[2][2];
            if (type == 1) {
#pragma unroll
                for (int bj = 0; bj < 2; ++bj)
#pragma unroll
                    for (int n = 0; n < 2; ++n) lb[bj][n] = *(const f32x4*)(LB + colb + bj * HALF + 4 * n);
            }
#pragma unroll
            for (int ai = 0; ai < 2; ++ai)
#pragma unroll
                for (int m = 0; m < 4; ++m) { const int row = row0 + ai * HALF + m * 16; const float rs = rsv[ai][m];
#pragma unroll
                    for (int bj = 0; bj < 2; ++bj) { f32x4 v0 = acc[ai][bj][m][0] * rs, v1 = acc[ai][bj][m][1] * rs; const size_t off = (size_t)row * 512 + colb + bj * HALF;
                        if (type == 1) {
#pragma unroll
                            for (int i = 0; i < 4; ++i) { const float l0 = lb[bj][0][i], l1 = lb[bj][1][i];
                                v0[i] = __logf(l0 + (1.0f - l0) * sigm(v0[i])); v1[i] = __logf(l1 + (1.0f - l1) * sigm(v1[i])); }
                            *(f32x4*)(LF + off) = v0; *(f32x4*)(LF + off + 4) = v1;
                        } else {
                            if (type != 2) {
#pragma unroll
                                for (int i = 0; i < 4; ++i) { v0[i] = silu_f(v0[i]); v1[i] = silu_f(v1[i]); } }
                            const int sel = (type == 0) ? 0 : (type == 2 ? 1 : 3);
                            bf16_t* dst = Q + (size_t)sel * ((size_t)MROWS * 512);
                            *(u32x4*)(dst + off) = pack8(v0, v1);
                        } } }
        } else {
            const int colb = (pn - 8) * 128 + wc * 32 + 8 * fq;
#pragma unroll
            for (int ai = 0; ai < 2; ++ai)
#pragma unroll
                for (int m = 0; m < 4; ++m) { const int row = row0 + ai * HALF + m * 16; const float rs = rsv[ai][m];
                    f32x4 g0, g1;
#pragma unroll
                    for (int i = 0; i < 4; ++i) { g0[i] = acc[ai][0][m][0][i] * rs * sigm(acc[ai][1][m][0][i] * rs); g1[i] = acc[ai][0][m][1][i] * rs * sigm(acc[ai][1][m][1][i] * rs); }
                    *(u32x4*)(GLU + (size_t)row * 512 + colb) = pack8(g0, g1); }
        }
    }
};
__device__ __forceinline__ const float* resid_row(const float* xp, const float* meta, const float* xs, int row) {
    return row < ROWS_REAL ? xp + (size_t)row * 1024 : (row < ROW_SAMP ? meta + (size_t)(row - ROW_META) * 1024 : (row < ROWS_USED ? xs + (size_t)(row - ROW_SAMP) * 1024 : nullptr));
}
struct EpiOut {
    static constexpr bool PERM = true, AFTER_DRAIN = false;
    const float *xp, *meta, *xs; bf16_t* HB; float* SS;
    __device__ __forceinline__ void operator()(const f32x4 (&acc)[2][2][4][2], const Unit& u, int wr, int wc, int fr, int fq) const {
        const int row0 = u.pm * BM + wr * 64 + fr; const int colb = u.pn * BM + wc * 32 + 8 * fq;
#pragma unroll
        for (int ai = 0; ai < 2; ++ai) {
            f32x4 rv[4][2][2];
#pragma unroll
            for (int m = 0; m < 4; ++m) { const int row = row0 + ai * HALF + m * 16; const float* rp = resid_row(xp, meta, xs, row);
#pragma unroll
                for (int bj = 0; bj < 2; ++bj) { const int col = colb + bj * HALF;
                    rv[m][bj][0] = rp ? __builtin_nontemporal_load((const f32x4*)(rp + col)) : (f32x4){0.f, 0.f, 0.f, 0.f}; rv[m][bj][1] = rp ? __builtin_nontemporal_load((const f32x4*)(rp + col + 4)) : (f32x4){0.f, 0.f, 0.f, 0.f}; } }
#pragma unroll
            for (int m = 0; m < 4; ++m) { const int row = row0 + ai * HALF + m * 16; float ss = 0.f;
#pragma unroll
                for (int bj = 0; bj < 2; ++bj) { const int col = colb + bj * HALF; const f32x4 v0 = acc[ai][bj][m][0] + rv[m][bj][0], v1 = acc[ai][bj][m][1] + rv[m][bj][1];
                    ss += (v0[0] * v0[0] + v0[1] * v0[1]) + (v0[2] * v0[2] + v0[3] * v0[3]) + (v1[0] * v1[0] + v1[1] * v1[1]) + (v1[2] * v1[2] + v1[3] * v1[3]);
                    *(u32x4*)(HB + (size_t)row * 1024 + col) = pack8(v0, v1); }
                ss += __shfl_xor(ss, 16); ss += __shfl_xor(ss, 32);
                if (fq == 0) atomicAdd(SS + row, ss); }
        }
    }
};
struct EpiUp {
    static constexpr bool PERM = true, AFTER_DRAIN = false;
    bf16_t* HID; const float* SS;
    __device__ __forceinline__ void operator()(const f32x4 (&acc)[2][2][4][2], const Unit& u, int wr, int wc, int fr, int fq) const {
        const int row0 = u.pm * BM + wr * 64 + fr; const int colb = u.pn * BM + wc * 32 + 8 * fq;
        float ssv[2][4];
#pragma unroll
        for (int ai = 0; ai < 2; ++ai)
#pragma unroll
            for (int m = 0; m < 4; ++m) ssv[ai][m] = SS[row0 + ai * HALF + m * 16];
#pragma unroll
        for (int ai = 0; ai < 2; ++ai)
#pragma unroll
            for (int m = 0; m < 4; ++m) { const int row = row0 + ai * HALF + m * 16; const float rs = __builtin_amdgcn_rsqf(ssv[ai][m] * (1.0f / 1024.0f) + 1e-6f);
#pragma unroll
                for (int bj = 0; bj < 2; ++bj) { f32x4 v0 = acc[ai][bj][m][0] * rs, v1 = acc[ai][bj][m][1] * rs;
#pragma unroll
                    for (int i = 0; i < 4; ++i) { const float a = fmaxf(v0[i], 0.f), b = fmaxf(v1[i], 0.f); v0[i] = a * a; v1[i] = b * b; }
                    *(u32x4*)(HID + (size_t)row * 4096 + colb + bj * HALF) = pack8(v0, v1); } }
    }
};
struct EpiDown {
    static constexpr bool PERM = true, AFTER_DRAIN = false;
    const bf16_t* HB; float* yp; float* ys; float* SS;
    __device__ __forceinline__ void operator()(const f32x4 (&acc)[2][2][4][2], const Unit& u, int wr, int wc, int fr, int fq) const {
        const int row0 = u.pm * BM + wr * 64 + fr; const int colb = u.pn * BM + wc * 32 + 8 * fq;
#pragma unroll
        for (int ai = 0; ai < 2; ++ai)
#pragma unroll
            for (int m = 0; m < 4; ++m) { const int row = row0 + ai * HALF + m * 16;
                float* op = row < ROWS_REAL ? yp + (size_t)row * 1024 : ((row >= ROW_SAMP && row < ROWS_USED) ? ys + (size_t)(row - ROW_SAMP) * 1024 : nullptr);
                if (op) { float ss = 0.f;
#pragma unroll
                    for (int bj = 0; bj < 2; ++bj) { const int col = colb + bj * HALF; const size_t off = (size_t)row * 1024 + col;
                        const u32x4 hb = *(const u32x4*)(HB + off);
                        const f32x4 v0 = acc[ai][bj][m][0] + (f32x4){__builtin_bit_cast(float, hb.x << 16), __builtin_bit_cast(float, hb.x & 0xffff0000u), __builtin_bit_cast(float, hb.y << 16), __builtin_bit_cast(float, hb.y & 0xffff0000u)},
                                    v1 = acc[ai][bj][m][1] + (f32x4){__builtin_bit_cast(float, hb.z << 16), __builtin_bit_cast(float, hb.z & 0xffff0000u), __builtin_bit_cast(float, hb.w << 16), __builtin_bit_cast(float, hb.w & 0xffff0000u)};
                        ss += (v0[0] * v0[0] + v0[1] * v0[1]) + (v0[2] * v0[2] + v0[3] * v0[3]) + (v1[0] * v1[0] + v1[1] * v1[1]) + (v1[2] * v1[2] + v1[3] * v1[3]);
                        *(f32x4*)(op + col) = v0; *(f32x4*)(op + col + 4) = v1; }
                    ss += __shfl_xor(ss, 16); ss += __shfl_xor(ss, 32);
                    if (fq == 0) atomicAdd(SS + row, ss); } }
    }
};
struct EpiDownF {
    static constexpr bool PERM = true, AFTER_DRAIN = true;
    const bf16_t* HB; float* yp; float* SS; unsigned* cnt; const float* fg;
    __device__ __forceinline__ void fused(f32x4 (&acc)[2][2][4][2], const Unit& u, int wr, int wc, int fr, int fq, PG8_LAS unsigned char* lds, int wid, int lane) const {
        const int row0 = u.pm * BM + wr * 64 + fr; const int colb = u.pn * BM + wc * 32 + 8 * fq;
        u32x4 hbv[2][4][2];
#pragma unroll
        for (int ai = 0; ai < 2; ++ai)
#pragma unroll
            for (int m = 0; m < 4; ++m)
#pragma unroll
                for (int bj = 0; bj < 2; ++bj) hbv[ai][m][bj] = __builtin_nontemporal_load((const u32x4*)(HB + (size_t)(row0 + ai * HALF + m * 16) * 1024 + colb + bj * HALF));
#pragma unroll
        for (int ai = 0; ai < 2; ++ai) {
#pragma unroll
            for (int m = 0; m < 4; ++m) { const int row = row0 + ai * HALF + m * 16; float ss = 0.f;
#pragma unroll
                for (int bj = 0; bj < 2; ++bj) { const u32x4 hb = hbv[ai][m][bj];
                    const f32x4 v0 = acc[ai][bj][m][0] + (f32x4){__builtin_bit_cast(float, hb.x << 16), __builtin_bit_cast(float, hb.x & 0xffff0000u), __builtin_bit_cast(float, hb.y << 16), __builtin_bit_cast(float, hb.y & 0xffff0000u)},
                                v1 = acc[ai][bj][m][1] + (f32x4){__builtin_bit_cast(float, hb.z << 16), __builtin_bit_cast(float, hb.z & 0xffff0000u), __builtin_bit_cast(float, hb.w << 16), __builtin_bit_cast(float, hb.w & 0xffff0000u)};
                    ss += (v0[0] * v0[0] + v0[1] * v0[1]) + (v0[2] * v0[2] + v0[3] * v0[3]) + (v1[0] * v1[0] + v1[1] * v1[1]) + (v1[2] * v1[2] + v1[3] * v1[3]);
                    acc[ai][bj][m][0] = v0; acc[ai][bj][m][1] = v1; }
                ss += __shfl_xor(ss, 16); ss += __shfl_xor(ss, 32);
                if (fq == 0) atomicAdd(SS + row, ss); }
        }
        asm volatile("s_waitcnt vmcnt(0)" ::: "memory");
        unsigned* c = cnt + 64 * u.pm;
        if (lane == 0) __hip_atomic_fetch_add(c, 1u, __ATOMIC_RELEASE, __HIP_MEMORY_SCOPE_AGENT);
        if (wid == 0) { unsigned sp = 0;
            while ((unsigned)__builtin_amdgcn_readfirstlane(__hip_atomic_load(c, __ATOMIC_RELAXED, __HIP_MEMORY_SCOPE_AGENT)) < 32u) { __builtin_amdgcn_s_sleep(2); if (++sp > (1u << 22)) break; }
            __builtin_amdgcn_fence(__ATOMIC_ACQUIRE, "agent"); }
        asm volatile("s_waitcnt vmcnt(0) lgkmcnt(0)" ::: "memory"); __builtin_amdgcn_s_barrier(); asm volatile("" ::: "memory");
        f32x4 g[2][2];
#pragma unroll
        for (int bj = 0; bj < 2; ++bj) { g[bj][0] = *(const f32x4*)(fg + colb + bj * HALF); g[bj][1] = *(const f32x4*)(fg + colb + bj * HALF + 4); }
        float ssv[2][4];
#pragma unroll
        for (int ai = 0; ai < 2; ++ai)
#pragma unroll
            for (int m = 0; m < 4; ++m) ssv[ai][m] = __hip_atomic_load(SS + row0 + ai * HALF + m * 16, __ATOMIC_RELAXED, __HIP_MEMORY_SCOPE_AGENT);
#pragma unroll
        for (int ai = 0; ai < 2; ++ai)
#pragma unroll
            for (int m = 0; m < 4; ++m) { const int row = row0 + ai * HALF + m * 16;
                const float rs = __builtin_amdgcn_rsqf(ssv[ai][m] * (1.0f / 1024.0f) + 1e-6f);
#pragma unroll
                for (int bj = 0; bj < 2; ++bj) { float* op = yp + (size_t)row * 1024 + colb + bj * HALF;
                    *(f32x4*)op = acc[ai][bj][m][0] * rs * g[bj][0]; *(f32x4*)(op + 4) = acc[ai][bj][m][1] * rs * g[bj][1]; } }
    }
};
template <class Epi, class Sched, bool ALIGN_EPI = false, bool SP2 = false>
__device__ __forceinline__ void gemm_phase(PG8_LAS unsigned char* lds, const Gemm g, const Sched& S, const Epi& E) {
    const int tid = threadIdx.x, wid = __builtin_amdgcn_readfirstlane(tid >> 6), lane = tid & 63, wr = wid >> 2, wc = wid & 3, fr = lane & 15, fq = lane >> 4;
    const int K = g.K, nt = K / BK;
    unsigned voffA[2], voffB[2];
#pragma unroll
    for (int i = 0; i < 2; ++i) { int R, C; stage_rc(tid * 16 + i * 8192, R, C); const int Rb = Epi::PERM ? ((R & ~31) + perm32(R & 31)) : R;
        voffA[i] = (unsigned)(R * K + C) * 2u; voffB[i] = (unsigned)(Rb * K + C) * 2u; }
    const size_t kstep = (size_t)(BK * 2);
    const size_t hstep = (size_t)HALF * K * 2;
    const size_t tstep = 2 * hstep;
    const unsigned ldsw = (unsigned)wid * 1024u;
    const int aoff = lds_byte(wr * 64 + fr, fq * 8), boff = lds_byte(wc * 32 + fr, fq * 8);
#define PG8_SA(b, h) (((b) * 2 + (h)) * HTB)
#define PG8_SB(b, h) ((4 + (b) * 2 + (h)) * HTB)
#define PG8_STAGE(bufoff, gbase, voff) do { _Pragma("unroll") for (int _i = 0; _i < 2; ++_i) \
        __builtin_amdgcn_global_load_lds((const unsigned*)((const char*)(gbase) + (voff)[_i]), (PG8_LAS unsigned*)(lds + (bufoff) + ldsw + _i * 8192), 16, 0, 0); } while (0)
#define PG8_LDA(dst, b, h) do { _Pragma("unroll") for (int m = 0; m < 4; ++m) _Pragma("unroll") for (int k = 0; k < 2; ++k) dst[m][k] = *(const PG8_LAS bf16x8*)(lds + PG8_SA(b, h) + aoff + m * 2048 + k * 1024); } while (0)
#define PG8_LDB(dst, b, h) do { _Pragma("unroll") for (int n = 0; n < 2; ++n) _Pragma("unroll") for (int k = 0; k < 2; ++k) dst[n][k] = *(const PG8_LAS bf16x8*)(lds + PG8_SB(b, h) + boff + n * 2048 + k * 1024); } while (0)
#define PG8_MMA(ai, bj, At, Bt) do { __builtin_amdgcn_s_setprio(1); _Pragma("unroll") for (int m = 0; m < 4; ++m) _Pragma("unroll") for (int n = 0; n < 2; ++n) _Pragma("unroll") for (int k = 0; k < 2; ++k) \
        acc[ai][bj][m][n] = __builtin_amdgcn_mfma_f32_16x16x32_bf16(Bt[n][k], At[m][k], acc[ai][bj][m][n], 0, 0, 0); __builtin_amdgcn_s_setprio(0); } while (0)
#define PG8_WAIT_V(n) asm volatile("s_waitcnt vmcnt(" #n ")" ::: "memory")
#define PG8_WAIT_L(n) asm volatile("s_waitcnt lgkmcnt(" #n ")" ::: "memory")
#define PG8_BAR __builtin_amdgcn_s_barrier()
#define PG8_SCHED __builtin_amdgcn_sched_barrier(0)
    Unit cur, nxt; int ui = 0;
    if (!S.next(0, cur)) return;
    f32x4 acc[2][2][4][2];
#pragma unroll
    for (int a = 0; a < 2; ++a)
#pragma unroll
        for (int b = 0; b < 2; ++b)
#pragma unroll
            for (int m = 0; m < 4; ++m)
#pragma unroll
                for (int n = 0; n < 2; ++n) acc[a][b][m][n] = (f32x4){0.f, 0.f, 0.f, 0.f};
    bf16x8 At[4][2], B0[2][2], B1[2][2];
    const char* cA = (const char*)g.A + (size_t)cur.pm * tstep; const char* cB = (const char*)g.Bt + (size_t)cur.pn * tstep;
    S.a_ready(cur);
    if constexpr (SP2) {
        PG8_STAGE(PG8_SB(0, 0), cB, voffB); PG8_STAGE(PG8_SB(0, 1), cB + hstep, voffB); PG8_STAGE(PG8_SA(0, 0), cA, voffA); PG8_STAGE(PG8_SA(0, 1), cA + hstep, voffA);
        if (wr == 1) PG8_BAR;
        PG8_WAIT_V(2); PG8_BAR;
        PG8_STAGE(PG8_SB(1, 0), cB + kstep, voffB); PG8_STAGE(PG8_SA(1, 0), cA + kstep, voffA); PG8_STAGE(PG8_SB(1, 1), cB + hstep + kstep, voffB);
        PG8_WAIT_V(6); PG8_BAR;
    } else {
        PG8_STAGE(PG8_SB(0, 0), cB, voffB); PG8_STAGE(PG8_SA(0, 0), cA, voffA); PG8_STAGE(PG8_SB(0, 1), cB + hstep, voffB); PG8_STAGE(PG8_SA(0, 1), cA + hstep, voffA);
        if (wr == 1) PG8_BAR;
        PG8_WAIT_V(4); PG8_BAR;
        PG8_STAGE(PG8_SB(1, 0), cB + kstep, voffB); PG8_STAGE(PG8_SA(1, 0), cA + kstep, voffA); PG8_STAGE(PG8_SB(1, 1), cB + hstep + kstep, voffB);
        PG8_WAIT_V(6); PG8_BAR;
    }
    for (;;) {
        const bool has_next = S.next(ui + 1, nxt);
        const char* nA = has_next ? (const char*)g.A + (size_t)nxt.pm * tstep : cA; const char* nB = has_next ? (const char*)g.Bt + (size_t)nxt.pn * tstep : cB;
        for (int t = 0; t < nt; t += 2) {
            const bool last = (t == nt - 2);
            const char* a1 = cA + (size_t)(t + 1) * kstep;
            const char* a2 = last ? nA : cA + (size_t)(t + 2) * kstep; const char* b2 = last ? nB : cB + (size_t)(t + 2) * kstep;
            const char* a3 = a2 + kstep; const char* b3 = b2 + kstep;
            if (last && has_next) S.a_ready(nxt);
            if constexpr (SP2) {
            PG8_LDB(B0, 0, 0); PG8_LDB(B1, 0, 1); PG8_SCHED; PG8_LDA(At, 0, 0); PG8_STAGE(PG8_SA(1, 1), a1 + hstep, voffA);
            PG8_WAIT_V(8); PG8_WAIT_L(0); PG8_BAR; PG8_MMA(0, 0, At, B0); PG8_MMA(0, 1, At, B1); PG8_BAR; PG8_SCHED;
            PG8_LDA(At, 0, 1); PG8_STAGE(PG8_SB(0, 0), b2, voffB); PG8_STAGE(PG8_SB(0, 1), b2 + hstep, voffB); PG8_STAGE(PG8_SA(0, 0), a2, voffA);
            PG8_WAIT_V(8); PG8_WAIT_L(0); PG8_BAR; PG8_MMA(1, 0, At, B0); PG8_MMA(1, 1, At, B1); PG8_BAR; PG8_SCHED;
            PG8_LDB(B0, 1, 0); PG8_LDB(B1, 1, 1); PG8_SCHED; PG8_LDA(At, 1, 0); PG8_STAGE(PG8_SA(0, 1), a2 + hstep, voffA);
            PG8_WAIT_V(8); PG8_WAIT_L(0); PG8_BAR; PG8_MMA(0, 0, At, B0); PG8_MMA(0, 1, At, B1); PG8_BAR; PG8_SCHED;
            PG8_LDA(At, 1, 1); PG8_STAGE(PG8_SB(1, 0), b3, voffB); PG8_STAGE(PG8_SB(1, 1), b3 + hstep, voffB); PG8_STAGE(PG8_SA(1, 0), a3, voffA);
            PG8_WAIT_V(8); PG8_WAIT_L(0); PG8_BAR; PG8_MMA(1, 0, At, B0); PG8_MMA(1, 1, At, B1); PG8_BAR; PG8_SCHED;
            } else {
            PG8_LDB(B0, 0, 0); PG8_SCHED; PG8_LDA(At, 0, 0); PG8_STAGE(PG8_SA(1, 1), a1 + hstep, voffA);
            PG8_WAIT_L(8); PG8_BAR; PG8_WAIT_L(0); PG8_MMA(0, 0, At, B0); PG8_BAR; PG8_SCHED;
            PG8_LDB(B1, 0, 1); PG8_STAGE(PG8_SB(0, 0), b2, voffB);
            PG8_BAR; PG8_WAIT_L(0); PG8_MMA(0, 1, At, B1); PG8_BAR;
            PG8_LDA(At, 0, 1); PG8_STAGE(PG8_SA(0, 0), a2, voffA);
            PG8_BAR; PG8_WAIT_L(0); PG8_MMA(1, 0, At, B0); PG8_BAR; PG8_SCHED;
            PG8_STAGE(PG8_SB(0, 1), b2 + hstep, voffB);
            PG8_WAIT_V(6); PG8_BAR; PG8_MMA(1, 1, At, B1); PG8_BAR;
            PG8_LDB(B0, 1, 0); PG8_SCHED; PG8_LDA(At, 1, 0); PG8_STAGE(PG8_SA(0, 1), a2 + hstep, voffA);
            PG8_WAIT_L(8); PG8_BAR; PG8_WAIT_L(0); PG8_MMA(0, 0, At, B0); PG8_BAR; PG8_SCHED;
            PG8_LDB(B1, 1, 1); PG8_STAGE(PG8_SB(1, 0), b3, voffB);
            PG8_BAR; PG8_WAIT_L(0); PG8_MMA(0, 1, At, B1); PG8_BAR;
            PG8_LDA(At, 1, 1); PG8_STAGE(PG8_SA(1, 0), a3, voffA);
            PG8_BAR; PG8_WAIT_L(0); PG8_MMA(1, 0, At, B0); PG8_BAR; PG8_SCHED;
            PG8_STAGE(PG8_SB(1, 1), b3 + hstep, voffB);
            PG8_WAIT_V(6); PG8_BAR; PG8_MMA(1, 1, At, B1); PG8_BAR;
            }
        }
        if constexpr (ALIGN_EPI) { if (wr == 0) PG8_BAR; }
        if constexpr (!Epi::AFTER_DRAIN) { E(acc, cur, wr, wc, fr, fq); S.done(cur); }
        if (!has_next) break;
#pragma unroll
        for (int a = 0; a < 2; ++a)
#pragma unroll
            for (int b = 0; b < 2; ++b)
#pragma unroll
                for (int m = 0; m < 4; ++m)
#pragma unroll
                    for (int n = 0; n < 2; ++n) acc[a][b][m][n] = (f32x4){0.f, 0.f, 0.f, 0.f};
        cur = nxt; cA = nA; cB = nB; ++ui;
        if constexpr (ALIGN_EPI) { if (wr == 1) PG8_BAR; }
    }
    PG8_WAIT_V(0);
    if constexpr (!ALIGN_EPI) { if (wr == 0) PG8_BAR; }
    PG8_BAR;
    if constexpr (Epi::AFTER_DRAIN) { E.fused(acc, cur, wr, wc, fr, fq, lds, wid, lane); S.done(cur); }
#undef PG8_SA
#undef PG8_SB
#undef PG8_STAGE
#undef PG8_LDA
#undef PG8_LDB
#undef PG8_MMA
#undef PG8_WAIT_V
#undef PG8_WAIT_L
#undef PG8_BAR
#undef PG8_SCHED
}
}

#define LAS __attribute__((address_space(3)))
typedef unsigned short bf16;
typedef unsigned v4u __attribute__((ext_vector_type(4)));
typedef unsigned v2u __attribute__((ext_vector_type(2)));
typedef float f32x4 __attribute__((ext_vector_type(4)));
typedef short bf16x8 __attribute__((ext_vector_type(8)));
constexpr int NWAVES = 8, NTHR = 512;
constexpr int D = 1024, NIN = 3072, FF = 4096, HW = 512;
constexpr int ROWS_REAL = pg8::ROWS_REAL, ROW_META = pg8::ROW_META, ROW_SAMP = pg8::ROW_SAMP, ROWS_USED = pg8::ROWS_USED, MROWS = pg8::MROWS;
constexpr int NB = 8, SEQ = 2048, NCH = 32, NSAMP = 128;
constexpr float EPS = 1e-6f;
constexpr int LDS_BYTES = 147456;

constexpr size_t KiB = 1024, MiB = 1u << 20;
constexpr size_t OFF_BAR = 768 * KiB, OFF_CNT = 784 * KiB, BAR_BYTES = 32 * KiB;
constexpr size_t OFF_SS2 = 0, OFF_SS3 = 128 * KiB, OFF_RS1 = 256 * KiB, OFF_LB = 384 * KiB, OFF_DSM = 512 * KiB;
constexpr size_t WS_WIN = 1 * MiB, WS_WOUT = 7 * MiB, WS_WUP = 9 * MiB, WS_WDN = 17 * MiB;
constexpr size_t WS_XB = 25 * MiB;
constexpr size_t WS_DS = 25 * MiB;
constexpr size_t WS_DEC = 89 * MiB;
constexpr size_t WS_LF = 89 * MiB + 512 * KiB;
constexpr size_t WS_SST = WS_LF;
constexpr size_t SZH = (size_t)MROWS * 512 * 2;
constexpr size_t WS_Q = 122 * MiB, WS_V = WS_Q + SZH, WS_GLU = WS_V + SZH, WS_G = WS_GLU + SZH, WS_QD = WS_G + SZH, WS_OI = WS_QD + SZH, WS_YM = WS_OI + SZH;
constexpr size_t WS_H1 = 25 * MiB;
constexpr size_t WS_HB = 90 * MiB;
constexpr size_t WS_HID = 122 * MiB + 512 * KiB;
constexpr size_t WS_ACC = 253 * MiB;
constexpr size_t WS_H1S = 253 * MiB + 512 * KiB;
constexpr size_t WS_HIDS = 254 * MiB + 128 * KiB;
constexpr size_t WS_END = 255 * MiB + 512 * KiB;
static_assert(WS_YM + 2 * SZH <= 252 * MiB + 1 && WS_HID + (size_t)MROWS * FF * 2 <= WS_END && WS_LF + (size_t)MROWS * 512 * 4 <= WS_Q, "ws map");

struct Args {
    const float *x_prompt, *x_sample, *state_hgrn, *state_conv, *meta, *hg_lb, *norm1_g, *w_in, *hg_onorm_g, *conv_w, *conv_b, *conv_ln_g, *conv_ln_b, *w_out, *norm2_g, *w_up, *w_down, *final_g;
    float* out; unsigned char* ws; int ph_lo, ph_hi, coop, pad;
};
constexpr size_t O_YP = 0, O_YS = (size_t)ROWS_REAL * D, O_SHP = O_YS + (size_t)NSAMP * D, O_SCP = O_SHP + (size_t)NB * 4 * 128 * 128, O_SHS = O_SCP + (size_t)NB * 30 * 512, O_SCS = O_SHS + (size_t)NSAMP * 4 * 128 * 128;

__device__ __forceinline__ unsigned f2bf(float f) { unsigned u = __builtin_bit_cast(unsigned, f); return (u + 0x7fffu + ((u >> 16) & 1u)) >> 16; }
typedef __bf16 hwbf16x2 __attribute__((ext_vector_type(2)));
typedef float hwf32x2 __attribute__((ext_vector_type(2)));
__device__ __forceinline__ unsigned pk2(float lo, float hi) { const hwf32x2 v = {lo, hi}; return __builtin_bit_cast(unsigned, __builtin_convertvector(v, hwbf16x2)); }
__device__ __forceinline__ float bf2f(unsigned short b) { return __builtin_bit_cast(float, (unsigned)b << 16); }
__device__ __forceinline__ float bflo(unsigned w) { return __builtin_bit_cast(float, w << 16); }
__device__ __forceinline__ float bfhi(unsigned w) { return __builtin_bit_cast(float, w & 0xffff0000u); }
__device__ __forceinline__ float wave_sum(float v) {
#pragma unroll
    for (int o = 1; o < 64; o <<= 1) v += __shfl_xor(v, o);
    return v;
}
#define LDS_WAIT() asm volatile("s_waitcnt lgkmcnt(0)" ::: "memory")

#define XB_TMO      128
#define XB_XCNT(j)  (256  + 64 * (j))
#define XB_XSUB(j)  (1280 + 64 * (j))
#define XB_XGEN(j)  (2304 + 64 * (j))
#define XB_TOP      3328
#define XB_TOPGEN   3392
#define XCD_BAR_WORDS 3456
#define XB_SPIN_CAP (1u << 18)

__device__ __forceinline__ unsigned xb_ld(unsigned* p)              { return __hip_atomic_load(p, __ATOMIC_RELAXED, __HIP_MEMORY_SCOPE_AGENT); }
__device__ __forceinline__ unsigned xb_add(unsigned* p, unsigned v) { return __hip_atomic_fetch_add(p, v, __ATOMIC_RELAXED, __HIP_MEMORY_SCOPE_AGENT); }
__device__ __forceinline__ unsigned xb_xcc_id() { return (unsigned)__builtin_amdgcn_s_getreg((3 << 11) | 20) & 0xFu; }
#define XB_SPIN(cond, bar) do { unsigned _sp = 0; while (cond) { __builtin_amdgcn_s_sleep(1); \
    if ((++_sp & 255u) == 0u) { if (xb_ld(&(bar)[XB_TMO])) break; if (_sp > XB_SPIN_CAP) { atomicAdd(&(bar)[XB_TMO], 1u); break; } } } } while (0)

struct XcdBarrier {
    unsigned* bar; unsigned x;
    volatile LAS unsigned* st;
};

__device__ __forceinline__ XcdBarrier xcd_barrier_post(unsigned* bar, volatile LAS unsigned* st) {
    XcdBarrier b; b.bar = bar; b.x = xb_xcc_id(); b.st = st;
    if (threadIdx.x == 0) (void)xb_add(&bar[XB_XCNT(b.x)], 1u);
    return b;
}
__device__ __forceinline__ void xcd_barrier_complete(unsigned* bar, unsigned x, unsigned& nloc, unsigned& nx) {
    const unsigned G = gridDim.x * gridDim.y * gridDim.z;
    unsigned sum, cnt, mine, sp = 0u;
    for (;;) {
        sum = 0u; cnt = 0u; mine = 0u;
#pragma unroll
        for (unsigned j = 0; j < 16; ++j) { const unsigned c = xb_ld(&bar[XB_XCNT(j)]); sum += c; cnt += (c > 0u) ? 1u : 0u; mine = (j == x) ? c : mine; }
        if (sum == G) break;
        __builtin_amdgcn_s_sleep(1);
        if ((++sp & 255u) == 0u) { if (xb_ld(&bar[XB_TMO])) break; if (sp > XB_SPIN_CAP) { atomicAdd(&bar[XB_TMO], 1u); break; } }
    }
    nloc = mine > 0u ? mine : 1u; nx = cnt > 0u ? cnt : 1u;
}

__device__ __forceinline__ void xcd_barrier(const XcdBarrier& b) {
    asm volatile("s_waitcnt vmcnt(0)" ::: "memory");
    __syncthreads();
    if (threadIdx.x == 0) {
        unsigned* bar = b.bar;
        __builtin_amdgcn_s_waitcnt(0);
        unsigned nloc = b.st[0], nx = b.st[1];
        if (nloc == 0u) { xcd_barrier_complete(bar, b.x, nloc, nx); b.st[0] = nloc; b.st[1] = nx; }
        const unsigned old = xb_add(&bar[XB_XSUB(b.x)], 1u);
        const unsigned gen = old / nloc;
        if (old + 1u == (gen + 1u) * nloc) {
            __builtin_amdgcn_fence(__ATOMIC_RELEASE, "agent");
            asm volatile("s_waitcnt vmcnt(0)" ::: "memory");
            const unsigned og = xb_add(&bar[XB_TOP], 1u);
            const unsigned tg = og / nx;
            if (og + 1u == (tg + 1u) * nx) xb_add(&bar[XB_TOPGEN], 1u);
            else XB_SPIN(xb_ld(&bar[XB_TOPGEN]) == tg, bar);
            __builtin_amdgcn_fence(__ATOMIC_ACQUIRE, "agent");
            xb_add(&bar[XB_XGEN(b.x)], 1u);
            asm volatile("s_waitcnt vmcnt(0)" ::: "memory");
        } else {
            XB_SPIN(xb_ld(&bar[XB_XGEN(b.x)]) == gen, bar);
            __builtin_amdgcn_fence(__ATOMIC_ACQUIRE, "agent");
            asm volatile("s_waitcnt vmcnt(0)" ::: "memory");
        }
    }
    __syncthreads();
}

template <bool IN_PERM>
__device__ __forceinline__ void p0_transpose_item(const float* W, const float* g, int K, int N, bf16* WT, LAS float* scr, int item, int lane) {
    const int nblk = N / 32, kb = item / nblk, nb = item % nblk, k0 = 64 * kb, n0 = 32 * nb;
    int s0 = n0;
    if (IN_PERM && n0 >= 2048) { const int j = (n0 - 2048) >> 8, w = (n0 - 2048) & 255; s0 = (w < 128) ? 2048 + 128 * j + w : 2560 + 128 * j + (w - 128); }
    float wv[32], gv[32];
#pragma unroll
    for (int i = 0; i < 32; ++i) { const int kk = 2 * i + (lane >> 5); wv[i] = __builtin_nontemporal_load(W + (size_t)(k0 + kk) * N + s0 + (lane & 31)); gv[i] = g ? g[k0 + kk] : 1.0f; }
#pragma unroll
    for (int i = 0; i < 32; ++i) { const int kk = 2 * i + (lane >> 5); scr[kk * 33 + (lane & 31)] = gv[i] * wv[i]; }
    LDS_WAIT(); asm volatile("" ::: "memory");
    const int c = lane & 7;
#pragma unroll
    for (int j = 0; j < 4; ++j) { const int n = (lane >> 3) + 8 * j; const LAS float* s = scr + (8 * c) * 33 + n;
        v4u o; o.x = pk2(s[0 * 33], s[1 * 33]); o.y = pk2(s[2 * 33], s[3 * 33]); o.z = pk2(s[4 * 33], s[5 * 33]); o.w = pk2(s[6 * 33], s[7 * 33]);
        *(v4u*)(WT + (size_t)(n0 + n) * K + k0 + 8 * c) = o; }
    LDS_WAIT(); asm volatile("" ::: "memory");
}
__device__ __forceinline__ void p0_prologue(const Args& a, LAS unsigned char* lds, int tid, int lane, int wave) {
    unsigned char* ws = a.ws;
    const int gw = blockIdx.x * NWAVES + wave, NGW = gridDim.x * NWAVES; const int gt = blockIdx.x * NTHR + tid, NGT = gridDim.x * NTHR;
    float* SS2 = (float*)(ws + OFF_SS2); float* SS3 = (float*)(ws + OFF_SS3); float* RS1 = (float*)(ws + OFF_RS1); float* LB = (float*)(ws + OFF_LB);
    for (int i = gt; i < MROWS; i += NGT) { SS2[i] = 0.f; SS3[i] = 0.f; }
    for (int i = gt; i < NSAMP * D / 4; i += NGT) ((f32x4*)(ws + WS_ACC))[i] = (f32x4){0.f, 0.f, 0.f, 0.f};
    if (gt < 512) { const float p0 = a.hg_lb[gt], p1 = a.hg_lb[512 + gt]; const float m = fmaxf(p0, p1), e0 = __expf(p0 - m), e1 = __expf(p1 - m); LB[gt] = e0 / (e0 + e1); }
    LAS float* scr = (LAS float*)(lds + wave * 16384);
    constexpr int I_IN = (D / 64) * (NIN / 32), I_OUT = (D / 64) * (D / 32), I_UP = (D / 64) * (FF / 32), I_DN = (FF / 64) * (D / 32);
    constexpr int NITEMS = I_IN + I_OUT + I_UP + I_DN;
    for (int it = gw; it < NITEMS; it += NGW) {
        int r = it;
        if (r < I_IN) { p0_transpose_item<true>(a.w_in, a.norm1_g, D, NIN, (bf16*)(ws + WS_WIN), scr, r, lane); continue; } r -= I_IN;
        if (r < I_OUT) { p0_transpose_item<false>(a.w_out, nullptr, D, D, (bf16*)(ws + WS_WOUT), scr, r, lane); continue; } r -= I_OUT;
        if (r < I_UP) { p0_transpose_item<false>(a.w_up, a.norm2_g, D, FF, (bf16*)(ws + WS_WUP), scr, r, lane); continue; } r -= I_UP;
        p0_transpose_item<false>(a.w_down, nullptr, FF, D, (bf16*)(ws + WS_WDN), scr, r, lane);
    }
    bf16* XB = (bf16*)(ws + WS_XB);
    {
        f32x4 v[4][4]; const float* xr[4]; int mb = gw;
#define P0_LOAD(mb_) do { _Pragma("unroll") for (int r = 0; r < 4; ++r) { const int m = (mb_) + r * NGW; xr[r] = m < MROWS ? pg8::resid_row(a.x_prompt, a.meta, a.x_sample, m) : nullptr; \
            _Pragma("unroll") for (int j = 0; j < 4; ++j) v[r][j] = xr[r] ? __builtin_nontemporal_load((const f32x4*)xr[r] + lane + 64 * j) : (f32x4){0.f, 0.f, 0.f, 0.f}; } } while (0)
        P0_LOAD(mb);
        while (mb < MROWS) {
            f32x4 c[4][4]; bool has[4]; const int cmb = mb;
#pragma unroll
            for (int r = 0; r < 4; ++r) { has[r] = xr[r] != nullptr;
#pragma unroll
                for (int j = 0; j < 4; ++j) c[r][j] = v[r][j]; }
            mb += NGW * 4; if (mb < MROWS) P0_LOAD(mb);
#pragma unroll
            for (int r = 0; r < 4; ++r) { const int m = cmb + r * NGW; if (m >= MROWS) break; float s = 0.f;
#pragma unroll
                for (int j = 0; j < 4; ++j) s += (c[r][j].x * c[r][j].x + c[r][j].y * c[r][j].y) + (c[r][j].z * c[r][j].z + c[r][j].w * c[r][j].w);
                s = wave_sum(s);
                if (lane == 0) RS1[m] = has[r] ? __builtin_amdgcn_rsqf(s * (1.0f / D) + EPS) : 0.f;
                unsigned long long* o8 = (unsigned long long*)(XB + (size_t)m * D) + lane;
#pragma unroll
                for (int j = 0; j < 4; ++j) o8[64 * j] = (unsigned long long)pk2(c[r][j].x, c[r][j].y) | ((unsigned long long)pk2(c[r][j].z, c[r][j].w) << 32); }
        }
#undef P0_LOAD
    }
}

template <int M0 = 0, int NT = 9>
__device__ __forceinline__ void skinny_slab(const bf16* A, int lda, const bf16* Bt, int ldb, int n0, int k_off, LAS unsigned char* lds, int wave, int lane, f32x4& r0, f32x4& r1, int arow0 = ROW_META) {
    const int fr = lane & 15, fq = lane >> 4; const int kb = k_off + wave * 128 + 8 * fq;
    const bf16* bp = Bt + (size_t)(n0 + fr) * ldb + kb; const bf16* ap = A + (size_t)(arow0 + 16 * M0 + fr) * lda + kb;
    bf16x8 fb[4], fa[4][NT];
#pragma unroll
    for (int ks = 0; ks < 4; ++ks) { fb[ks] = *(const bf16x8*)(bp + 32 * ks);
#pragma unroll
        for (int m = 0; m < NT; ++m) fa[ks][m] = *(const bf16x8*)(ap + (size_t)(16 * m) * lda + 32 * ks); }
    f32x4 acc[NT];
#pragma unroll
    for (int m = 0; m < NT; ++m) acc[m] = (f32x4){0.f, 0.f, 0.f, 0.f};
#pragma unroll
    for (int ks = 0; ks < 4; ++ks)
#pragma unroll
        for (int m = 0; m < NT; ++m) acc[m] = __builtin_amdgcn_mfma_f32_16x16x32_bf16(fb[ks], fa[ks][m], acc[m], 0, 0, 0);
    LAS f32x4* red = (LAS f32x4*)lds;
#pragma unroll
    for (int m = 0; m < NT; ++m) red[(wave * NT + m) * 64 + lane] = acc[m];
    __syncthreads();
    r0 = (f32x4){0.f, 0.f, 0.f, 0.f}; r1 = r0;
    if (wave < NT) {
#pragma unroll
        for (int w = 0; w < 8; ++w) r0 += red[(w * NT + wave) * 64 + lane]; }
    if (NT == 9 && wave == 0) {
#pragma unroll
        for (int w = 0; w < 8; ++w) r1 += red[(w * NT + 8) * 64 + lane]; }
    __syncthreads();
}
__device__ __forceinline__ v2u pack4(const f32x4 v) { return (v2u){pk2(v[0], v[1]), pk2(v[2], v[3])}; }
__device__ __forceinline__ void skinny_in(const Args& a, LAS unsigned char* lds, int u, int lane, int wave) {
    unsigned char* ws = a.ws; const bf16* XB = (const bf16*)(ws + WS_XB); const bf16* W = (const bf16*)(ws + WS_WIN); const float* RS1 = (const float*)(ws + OFF_RS1);
    const int fr = lane & 15, fq = lane >> 4;
    if (u < 128) {
        const int n0 = 16 * u, type = n0 >> 9, cw = (n0 & 511) + 4 * fq;
        f32x4 r[2]; skinny_slab(XB, D, W, D, n0, 0, lds, wave, lane, r[0], r[1]);
        f32x4 lb = {0.f, 0.f, 0.f, 0.f}; if (type == 1) lb = *(const f32x4*)((const float*)(ws + OFF_LB) + cw);
#pragma unroll
        for (int x = 0; x < 2; ++x) { if (x == 1 && wave != 0) break; const int row = ROW_META + 16 * (x ? 8 : wave) + fr; const float rs = RS1[row]; f32x4 v = r[x] * rs; const size_t off = (size_t)row * 512 + cw;
            if (type == 1) {
#pragma unroll
                for (int i = 0; i < 4; ++i) v[i] = __logf(lb[i] + (1.0f - lb[i]) * pg8::sigm(v[i]));
                *(f32x4*)((float*)(ws + WS_LF) + off) = v;
            } else {
                if (type != 2) {
#pragma unroll
                    for (int i = 0; i < 4; ++i) v[i] = pg8::silu_f(v[i]); }
                const int sel = (type == 0) ? 0 : (type == 2 ? 1 : 3);
                *(v2u*)((bf16*)(ws + WS_Q) + (size_t)sel * ((size_t)MROWS * 512) + off) = pack4(v); } }
    } else {
        const int p = (u - 128) >> 1, half = (u - 128) & 1, j = p >> 3, s = p & 7, n0 = 2048 + 256 * j + 16 * s;
        f32x4 ra, rb, dum;
        if (half == 0) { skinny_slab<0, 5>(XB, D, W, D, n0, 0, lds, wave, lane, ra, dum); skinny_slab<0, 5>(XB, D, W, D, n0 + 128, 0, lds, wave, lane, rb, dum); }
        else { skinny_slab<5, 4>(XB, D, W, D, n0, 0, lds, wave, lane, ra, dum); skinny_slab<5, 4>(XB, D, W, D, n0 + 128, 0, lds, wave, lane, rb, dum); }
        if (wave < (half ? 4 : 5)) { const int row = ROW_META + 16 * ((half ? 5 : 0) + wave) + fr; const float rs = RS1[row]; f32x4 g;
#pragma unroll
            for (int i = 0; i < 4; ++i) g[i] = ra[i] * rs * pg8::sigm(rb[i] * rs);
            *(v2u*)((bf16*)(ws + WS_GLU) + (size_t)row * 512 + 128 * j + 16 * s + 4 * fq) = pack4(g); }
    }
}
__device__ __forceinline__ void skinny_out(const Args& a, LAS unsigned char* lds, int u, int lane, int wave) {
    unsigned char* ws = a.ws; const int fr = lane & 15, fq = lane >> 4, n0 = 16 * (u & 63), grp = u >> 6;
    f32x4 r0, r1; const bf16* A = (const bf16*)(ws + WS_YM); const bf16* W = (const bf16*)(ws + WS_WOUT);
    if (grp == 0) skinny_slab<1, 2>(A, D, W, D, n0, 0, lds, wave, lane, r0, r1); else if (grp == 1) skinny_slab<3, 2>(A, D, W, D, n0, 0, lds, wave, lane, r0, r1);
    else if (grp == 2) skinny_slab<5, 2>(A, D, W, D, n0, 0, lds, wave, lane, r0, r1); else skinny_slab<7, 2>(A, D, W, D, n0, 0, lds, wave, lane, r0, r1);
    if (wave < 2) { const int row = ROW_META + 16 * (1 + 2 * grp + wave) + fr; const float* rp = pg8::resid_row(a.x_prompt, a.meta, a.x_sample, row);
        const f32x4 v = r0 + *(const f32x4*)(rp + n0 + 4 * fq); const size_t off = (size_t)row * D + n0 + 4 * fq;
        *(f32x4*)((float*)(ws + WS_H1S) + (size_t)(row - ROW_META) * D + n0 + 4 * fq) = v; *(v2u*)((bf16*)(ws + WS_HB) + off) = pack4(v);
        float ss = (v[0] * v[0] + v[1] * v[1]) + (v[2] * v[2] + v[3] * v[3]); ss += __shfl_xor(ss, 16); ss += __shfl_xor(ss, 32);
        if (fq == 0) atomicAdd((float*)(ws + OFF_SS2) + row, ss); }
}
__device__ __forceinline__ void skinny_up(const Args& a, LAS unsigned char* lds, int u, int lane, int wave) {
    unsigned char* ws = a.ws; const int fr = lane & 15, fq = lane >> 4, n0 = 16 * u;
    f32x4 r0, r1; skinny_slab<1, 8>((const bf16*)(ws + WS_HB), D, (const bf16*)(ws + WS_WUP), D, n0, 0, lds, wave, lane, r0, r1);
    const int row = ROW_SAMP + 16 * wave + fr; const float rs = __builtin_amdgcn_rsqf(((const float*)(ws + OFF_SS2))[row] * (1.0f / D) + EPS);
    f32x4 v = r0 * rs;
#pragma unroll
    for (int i = 0; i < 4; ++i) { const float t = fmaxf(v[i], 0.f); v[i] = t * t; }
    *(v2u*)((bf16*)(ws + WS_HIDS) + (size_t)(row - ROW_META) * FF + n0 + 4 * fq) = pack4(v);
}
__device__ __forceinline__ void skinny_down(const Args& a, LAS unsigned char* lds, int u, int lane, int wave) {
    unsigned char* ws = a.ws; const int fr = lane & 15, fq = lane >> 4, n0 = 16 * (u & 63), kc = u >> 6;
    f32x4 r0, r1; skinny_slab<1, 8>((const bf16*)(ws + WS_HIDS), FF, (const bf16*)(ws + WS_WDN), FF, n0, kc * 1024, lds, wave, lane, r0, r1, 0);
    float* p = (float*)(ws + WS_ACC) + (size_t)(16 * wave + fr) * D + n0 + 4 * fq;
#pragma unroll
    for (int i = 0; i < 4; ++i) atomicAdd(p + i, r0[i]);
}

constexpr int L_QD = 0, L_KI = 17408, L_KIT = 34816, L_VT = 55296, L_SC = 75776, L_PART = 84992, L_DEC = 93184;
__device__ __forceinline__ int tsw(int row, int chunk) { return row * 160 + 16 * (chunk ^ ((row >> 3) & 7)); }
__device__ __forceinline__ bf16x8 lds_frag(LAS unsigned char* base, int row, int stride_b, int kbyte) { return *(const LAS bf16x8*)(base + row * stride_b + kbyte); }
#define BAR_LDS() do { asm volatile("s_waitcnt lgkmcnt(0)" ::: "memory"); __builtin_amdgcn_s_barrier(); asm volatile("" ::: "memory"); } while (0)
struct ChunkIn { f32x4 lf[4]; v2u q[4], v[4]; };
__device__ __forceinline__ void chunk_load(const Args& a, int item, int tid, ChunkIn& in) {
    unsigned char* ws = a.ws; const bool meta = item >= 1024; const int h = meta ? item - 1024 : (item & 3), bn = meta ? 0 : (item >> 2);
    const float* LF = (const float*)(ws + WS_LF); const bf16* Q = (const bf16*)(ws + WS_Q); const bf16* V = (const bf16*)(ws + WS_V);
    const int c4 = tid & 31, ts = tid >> 5; const bool valid = !meta || ts >= 12;
    const size_t cbase = (size_t)(meta ? ROW_META + 4 * (ts - 12) : bn * 64 + 4 * ts) * 512 + h * 128 + 4 * c4;
#pragma unroll
    for (int i = 0; i < 4; ++i) { in.lf[i] = (f32x4){0.f, 0.f, 0.f, 0.f}; in.q[i] = (v2u){0u, 0u}; in.v[i] = (v2u){0u, 0u}; }
    if (valid) {
#pragma unroll
        for (int i = 0; i < 4; ++i) { in.lf[i] = __builtin_nontemporal_load((const f32x4*)(LF + cbase + (size_t)i * 512)); in.q[i] = __builtin_nontemporal_load((const v2u*)(Q + cbase + (size_t)i * 512)); in.v[i] = __builtin_nontemporal_load((const v2u*)(V + cbase + (size_t)i * 512)); } }
}
__device__ __forceinline__ void hgrn_chunk_item(const Args& a, LAS unsigned char* lds, int item, const ChunkIn& in, int tid, int lane, int wave) {
    unsigned char* ws = a.ws;
    const bool meta = item >= 1024; const int h = meta ? item - 1024 : (item & 3), bn = meta ? 0 : (item >> 2);
    bf16* QDg = (bf16*)(ws + WS_QD); bf16* OI = (bf16*)(ws + WS_OI); float* DEC = (float*)(ws + WS_DEC);
    bf16* DSo = meta ? (bf16*)(ws + OFF_DSM) + (size_t)h * 16384 : (bf16*)(ws + WS_DS) + ((size_t)bn * 4 + h) * 16384;
    const int c4 = tid & 31, ts = tid >> 5;
    const size_t cbase = (size_t)(bn * 64 + 4 * ts) * 512 + h * 128 + 4 * c4;
    LAS float* PART = (LAS float*)(lds + L_PART); LAS float* DECl = (LAS float*)(lds + L_DEC);
    f32x4 c[4];
    c[0] = in.lf[0]; c[1] = c[0] + in.lf[1]; c[2] = c[1] + in.lf[2]; c[3] = c[2] + in.lf[3];
    *(LAS f32x4*)(PART + ts * 128 + 4 * c4) = c[3];
    BAR_LDS();
    f32x4 off = {0.f, 0.f, 0.f, 0.f}, bend = off;
#pragma unroll
    for (int j = 0; j < 16; ++j) { const f32x4 pj = *(const LAS f32x4*)(PART + j * 128 + 4 * c4); bend += pj; if (j < ts) off += pj; }
    unsigned kiw[4][4];
#pragma unroll
    for (int i = 0; i < 4; ++i) {
        const f32x4 bcur = off + c[i]; f32x4 qd, ki;
        const f32x4 qf = {bflo(in.q[i].x), bfhi(in.q[i].x), bflo(in.q[i].y), bfhi(in.q[i].y)};
#pragma unroll
        for (int j = 0; j < 4; ++j) { const float e = __expf(bcur[j]); qd[j] = qf[j] * e; ki[j] = (1.0f - __expf(in.lf[i][j])) * __builtin_amdgcn_rcpf(e); }
        const int t = 4 * ts + i;
        const v2u qdp = {pk2(qd[0], qd[1]), pk2(qd[2], qd[3])}, kip = {pk2(ki[0], ki[1]), pk2(ki[2], ki[3])};
        *(LAS v2u*)(lds + L_QD + t * 272 + 8 * c4) = qdp; *(LAS v2u*)(lds + L_KI + t * 272 + 8 * c4) = kip;
        if (!meta) *(v2u*)(QDg + cbase + (size_t)i * 512) = qdp;
        kiw[0][i] = kip.x & 0xffffu; kiw[1][i] = kip.x >> 16; kiw[2][i] = kip.y & 0xffffu; kiw[3][i] = kip.y >> 16;
    }
#pragma unroll
    for (int j = 0; j < 4; ++j) {
        *(LAS v2u*)(lds + L_KIT + tsw(4 * c4 + j, ts >> 1) + 8 * (ts & 1)) = (v2u){kiw[j][0] | (kiw[j][1] << 16), kiw[j][2] | (kiw[j][3] << 16)};
        unsigned vb[4];
#pragma unroll
        for (int i = 0; i < 4; ++i) { const unsigned w = (j < 2) ? in.v[i].x : in.v[i].y; vb[i] = (j & 1) ? (w >> 16) : (w & 0xffffu); }
        *(LAS v2u*)(lds + L_VT + tsw(4 * c4 + j, ts >> 1) + 8 * (ts & 1)) = (v2u){vb[0] | (vb[1] << 16), vb[2] | (vb[3] << 16)};
    }
    if (ts == 0) { f32x4 dc;
#pragma unroll
        for (int j = 0; j < 4; ++j) dc[j] = __expf(bend[j]);
        *(LAS f32x4*)(DECl + 4 * c4) = dc; if (!meta) *(f32x4*)(DEC + (size_t)bn * 512 + h * 128 + 4 * c4) = dc; }
    BAR_LDS();
    const int fr = lane & 15, fq = lane >> 4;
    if (!meta) {
#pragma unroll
        for (int x = 0; x < 2; ++x) { const int idx = wave * 2 + x, tt = idx >> 2, st = idx & 3;
            f32x4 acc = {0.f, 0.f, 0.f, 0.f};
            if (st <= tt) {
#pragma unroll
                for (int ks = 0; ks < 4; ++ks) { const bf16x8 fa = lds_frag(lds + L_KI, 16 * st + fr, 272, 64 * ks + 16 * fq), fb = lds_frag(lds + L_QD, 16 * tt + fr, 272, 64 * ks + 16 * fq);
                    acc = __builtin_amdgcn_mfma_f32_16x16x32_bf16(fa, fb, acc, 0, 0, 0); }
                const int t = 16 * tt + fr, s0 = 16 * st + 4 * fq;
#pragma unroll
                for (int r = 0; r < 4; ++r) if (s0 + r > t) acc[r] = 0.f;
            }
            *(LAS v2u*)(lds + L_SC + (16 * tt + fr) * 144 + (16 * st + 4 * fq) * 2) = (v2u){pk2(acc[0], acc[1]), pk2(acc[2], acc[3])}; }
    }
    BAR_LDS();
    const int vt_i = wave;
    const bf16x8 fv0 = *(const LAS bf16x8*)(lds + L_VT + tsw(16 * vt_i + fr, fq)), fv1 = *(const LAS bf16x8*)(lds + L_VT + tsw(16 * vt_i + fr, 4 + fq));
    if (!meta) {
#pragma unroll
        for (int tt = 0; tt < 4; ++tt) { f32x4 acc = {0.f, 0.f, 0.f, 0.f};
            const bf16x8 s0 = lds_frag(lds + L_SC, 16 * tt + fr, 144, 16 * fq), s1 = lds_frag(lds + L_SC, 16 * tt + fr, 144, 64 + 16 * fq);
            acc = __builtin_amdgcn_mfma_f32_16x16x32_bf16(fv0, s0, acc, 0, 0, 0); acc = __builtin_amdgcn_mfma_f32_16x16x32_bf16(fv1, s1, acc, 0, 0, 0);
            *(v2u*)(OI + (size_t)(bn * 64 + 16 * tt + fr) * 512 + h * 128 + 16 * vt_i + 4 * fq) = (v2u){pk2(acc[0], acc[1]), pk2(acc[2], acc[3])}; }
    }
#pragma unroll
    for (int dt = 0; dt < 8; ++dt) { f32x4 acc = {0.f, 0.f, 0.f, 0.f};
        const bf16x8 k0 = *(const LAS bf16x8*)(lds + L_KIT + tsw(16 * dt + fr, fq)), k1 = *(const LAS bf16x8*)(lds + L_KIT + tsw(16 * dt + fr, 4 + fq));
        acc = __builtin_amdgcn_mfma_f32_16x16x32_bf16(k0, fv0, acc, 0, 0, 0); acc = __builtin_amdgcn_mfma_f32_16x16x32_bf16(k1, fv1, acc, 0, 0, 0);
        const f32x4 dc = *(const LAS f32x4*)(DECl + 16 * dt + 4 * fq);
        const f32x4 sc = acc * dc; *(v2u*)(DSo + (size_t)(16 * vt_i + fr) * 128 + 16 * dt + 4 * fq) = (v2u){pk2(sc[0], sc[1]), pk2(sc[2], sc[3])}; }
    BAR_LDS();
}

__device__ __forceinline__ void conv_item(const Args& a, LAS unsigned char* lds, int item, int tid, int lane, int wave) {
    unsigned char* ws = a.ws; const bf16* GLU = (const bf16*)(ws + WS_GLU); bf16* YM = (bf16*)(ws + WS_YM);
    const int b = item >> 5, g = item & 31, c = tid; const int r0 = b * SEQ + g * 64;
    float w[31];
#pragma unroll
    for (int j = 0; j < 31; ++j) w[j] = a.conv_w[j * 512 + c];
    const float bias = a.conv_b[c];
    LAS float* DW = (LAS float*)lds;
    LAS unsigned short* GW = (LAS unsigned short*)(lds + 65536);
    float lg[8], lb[8];
#pragma unroll
    for (int i = 0; i < 8; ++i) { lg[i] = a.conv_ln_g[8 * lane + i]; lb[i] = a.conv_ln_b[8 * lane + i]; }
    v4u stg[8];
#define CONV_LOAD(grp_) do { _Pragma("unroll") for (int k = 0; k < 8; ++k) { const int q = tid + 512 * k; const int rr = q >> 6, cc = (q & 63) * 8; stg[k] = (v4u){0u, 0u, 0u, 0u}; \
            if (rr < 62) { const int tp = g * 64 + 32 * (grp_) + rr - 30; \
                if (tp >= 0) stg[k] = *(const v4u*)(GLU + (size_t)(b * SEQ + tp) * 512 + cc); else if (tp >= -16) stg[k] = *(const v4u*)(GLU + (size_t)(ROW_META + 16 + tp) * 512 + cc); } } } while (0)
    CONV_LOAD(0);
    for (int grp = 0; grp < 2; ++grp) {
        const int rg = r0 + 32 * grp;
#pragma unroll
        for (int k = 0; k < 8; ++k) { const int q = tid + 512 * k; const int rr = q >> 6, cc = (q & 63) * 8; if (rr < 62) *(LAS v4u*)(GW + rr * 512 + cc) = stg[k]; }
        if (grp == 0) CONV_LOAD(1);
        BAR_LDS();
        if (g == 31 && grp == 1) {
#pragma unroll 1
            for (int i = 2; i < 32; ++i) a.out[O_SCP + (size_t)(b * 30 + i - 2) * 512 + c] = bf2f(GW[(30 + i) * 512 + c]); }
#pragma unroll 1
        for (int ib = 0; ib < 4; ++ib) {
            const LAS unsigned short* gp = GW + ib * 8 * 512 + c; LAS float* dp = DW + ib * 8 * 512 + c;
            float xv[38];
#pragma unroll
            for (int i = 0; i < 38; ++i) xv[i] = bf2f(gp[i * 512]);
#pragma unroll
            for (int i = 0; i < 8; ++i) {
                float acc = bias;
#pragma unroll
                for (int j = 0; j < 31; ++j) acc += w[j] * xv[i + j];
                dp[i * 512] = acc;
            }
        }
        __syncthreads();
#pragma unroll
        for (int rr = 0; rr < 4; ++rr) { const int i = wave + 8 * rr;
            const f32x4 x0 = *(const LAS f32x4*)(DW + i * 512 + 8 * lane), x1 = *(const LAS f32x4*)(DW + i * 512 + 8 * lane + 4);
            const float mean = wave_sum((x0[0] + x0[1]) + (x0[2] + x0[3]) + (x1[0] + x1[1]) + (x1[2] + x1[3])) * (1.0f / 512.0f);
            const f32x4 d0 = x0 - mean, d1 = x1 - mean;
            const float var = wave_sum((d0[0] * d0[0] + d0[1] * d0[1]) + (d0[2] * d0[2] + d0[3] * d0[3]) + (d1[0] * d1[0] + d1[1] * d1[1]) + (d1[2] * d1[2] + d1[3] * d1[3])) * (1.0f / 512.0f);
            const float rstd = __builtin_amdgcn_rsqf(var + EPS);
            float y[8];
#pragma unroll
            for (int k = 0; k < 4; ++k) { y[k] = pg8::silu_f(d0[k] * rstd * lg[k] + lb[k]); y[4 + k] = pg8::silu_f(d1[k] * rstd * lg[4 + k] + lb[4 + k]); }
            *(v4u*)(YM + (size_t)(rg + i) * 1024 + 512 + 8 * lane) = (v4u){pk2(y[0], y[1]), pk2(y[2], y[3]), pk2(y[4], y[5]), pk2(y[6], y[7])}; }
        __syncthreads();
    }
}

struct SConvIn { float xs[30], wv[31], glu, lg, lb, bias; };
__device__ __forceinline__ void sample_conv_load(const Args& a, int s, int tid, SConvIn& in) {
    const int c = tid; const float* sc = a.state_conv + (size_t)s * 30 * 512 + c;
#pragma unroll
    for (int j = 0; j < 30; ++j) { in.xs[j] = __builtin_nontemporal_load(sc + j * 512); in.wv[j] = a.conv_w[j * 512 + c]; }
    in.wv[30] = a.conv_w[30 * 512 + c];
    in.glu = bf2f(((const bf16*)(a.ws + WS_GLU))[(size_t)(ROW_SAMP + s) * 512 + c]);
    in.lg = a.conv_ln_g[c]; in.lb = a.conv_ln_b[c]; in.bias = a.conv_b[c];
}
__device__ __forceinline__ void sample_conv_item(const Args& a, LAS unsigned char* lds, int s, const SConvIn& in, int tid, int lane, int wave) {
    unsigned char* ws = a.ws; const int row = ROW_SAMP + s; bf16* YM = (bf16*)(ws + WS_YM);
    LAS float* RED = (LAS float*)(lds + 96 * 1024);
    const int c = tid; float* so = a.out + O_SCS + (size_t)s * 30 * 512 + c;
    float acc = in.bias;
#pragma unroll
    for (int j = 0; j < 30; ++j) acc += in.wv[j] * in.xs[j];
    acc += in.wv[30] * in.glu;
#pragma unroll
    for (int j = 1; j < 30; ++j) so[(j - 1) * 512] = in.xs[j];
    so[29 * 512] = in.glu;
    float sm = wave_sum(acc); if (lane == 0) RED[wave] = sm;
    BAR_LDS();
    float mean = 0.f;
#pragma unroll
    for (int j = 0; j < 8; ++j) mean += RED[j];
    mean *= (1.0f / 512.0f);
    const float dd = acc - mean; float sv = wave_sum(dd * dd); if (lane == 0) RED[8 + wave] = sv;
    BAR_LDS();
    float var = 0.f;
#pragma unroll
    for (int j = 0; j < 8; ++j) var += RED[8 + j];
    const float rstd = __builtin_amdgcn_rsqf(var * (1.0f / 512.0f) + EPS);
    YM[(size_t)row * 1024 + 512 + c] = (unsigned short)f2bf(pg8::silu_f(dd * rstd * in.lg + in.lb));
    BAR_LDS();
}
struct SampIn { f32x4 S[8]; f32x4 lf0, lf1; v4u q; v2u v; };
__device__ __forceinline__ void samp_load(const Args& a, int it, int tid, SampIn& in) {
    unsigned char* ws = a.ws; const int s = it >> 2, h = it & 3, vq = tid & 31, dg = tid >> 5; const size_t hb = (size_t)(ROW_SAMP + s) * 512 + h * 128;
    const float* Sin = a.state_hgrn + ((size_t)it * 128 + 8 * dg) * 128 + 4 * vq;
#pragma unroll
    for (int dd = 0; dd < 8; ++dd) in.S[dd] = __builtin_nontemporal_load((const f32x4*)(Sin + (size_t)dd * 128));
    const float* LF = (const float*)(ws + WS_LF) + hb + 8 * dg; in.lf0 = *(const f32x4*)LF; in.lf1 = *(const f32x4*)(LF + 4);
    in.q = *(const v4u*)((const bf16*)(ws + WS_Q) + hb + 8 * dg); in.v = *(const v2u*)((const bf16*)(ws + WS_V) + hb + 4 * vq);
}
__device__ __forceinline__ void samp_item(const Args& a, LAS unsigned char* lds, int it, const SampIn& in, int tid, int lane, int wave) {
    unsigned char* ws = a.ws; const int s = it >> 2, h = it & 3, vq = tid & 31, dg = tid >> 5; const int row = ROW_SAMP + s; const size_t hb = (size_t)row * 512 + h * 128;
    LAS float* OP = (LAS float*)(lds + 100 * 1024);
    float ga = 0.f, gb = 0.f, na = 0.f, nb = 0.f;
    if (wave == 0) { const bf16* G = (const bf16*)(ws + WS_G); ga = bf2f(G[hb + lane]); gb = bf2f(G[hb + 64 + lane]); na = a.hg_onorm_g[lane]; nb = a.hg_onorm_g[64 + lane]; }
    const f32x4 v4 = {bflo(in.v.x), bfhi(in.v.x), bflo(in.v.y), bfhi(in.v.y)};
    float* Sout = a.out + O_SHS + ((size_t)it * 128 + 8 * dg) * 128 + 4 * vq;
    f32x4 o4 = {0.f, 0.f, 0.f, 0.f};
#pragma unroll
    for (int dd = 0; dd < 8; ++dd) { const float lf = dd < 4 ? in.lf0[dd & 3] : in.lf1[dd & 3]; const unsigned qw = in.q[dd >> 1]; const float q = (dd & 1) ? bfhi(qw) : bflo(qw);
        const float f = __expf(lf), k = 1.0f - f; const f32x4 S = in.S[dd] * f + v4 * k; *(f32x4*)(Sout + (size_t)dd * 128) = S; o4 += S * q; }
    *(LAS f32x4*)(OP + dg * 128 + 4 * vq) = o4;
    BAR_LDS();
    if (wave == 0) { float oa = 0.f, ob = 0.f;
#pragma unroll
        for (int j = 0; j < 16; ++j) { oa += OP[j * 128 + lane]; ob += OP[j * 128 + 64 + lane]; }
        const float rstd = __builtin_amdgcn_rsqf(wave_sum(oa * oa + ob * ob) * (1.0f / 128.0f) + EPS);
        bf16* YM = (bf16*)(ws + WS_YM);
        YM[(size_t)row * 1024 + h * 128 + lane] = (unsigned short)f2bf(oa * rstd * na * ga); YM[(size_t)row * 1024 + h * 128 + 64 + lane] = (unsigned short)f2bf(ob * rstd * nb * gb); }
    BAR_LDS();
}

__device__ __forceinline__ void scan_phase(const Args& a, int tid) {
    unsigned char* ws = a.ws; const bf16* DS = (const bf16*)(ws + WS_DS); const bf16* DSM = (const bf16*)(ws + OFF_DSM); const float* DEC = (const float*)(ws + WS_DEC); bf16* SST = (bf16*)(ws + WS_SST);
    for (int e = blockIdx.x * NTHR + tid; e < NB * 4 * 128 * 32; e += gridDim.x * NTHR) {
        const int d4 = (e & 31) * 4, v = (e >> 5) & 127, h = (e >> 12) & 3, b = e >> 14;
        const v2u m0 = *(const v2u*)(DSM + (size_t)h * 16384 + v * 128 + d4);
        f32x4 S = {bflo(m0.x), bfhi(m0.x), bflo(m0.y), bfhi(m0.y)};
        const bf16* dsp = DS + ((size_t)(b * 32) * 4 + h) * 16384 + v * 128 + d4; bf16* ssp = SST + ((size_t)(b * 32) * 4 + h) * 16384 + v * 128 + d4; const float* dcp = DEC + (size_t)(b * 32) * 512 + h * 128 + d4;
        {
            v2u ds[8]; f32x4 dc[8];
#define SCAN_LOAD(n0_) do { _Pragma("unroll") for (int i = 0; i < 8; ++i) { ds[i] = __builtin_nontemporal_load((const v2u*)(dsp + (size_t)((n0_) + i) * 65536)); dc[i] = *(const f32x4*)(dcp + (size_t)((n0_) + i) * 512); } } while (0)
            SCAN_LOAD(0);
#pragma unroll 1
            for (int n0 = 0; n0 < NCH; n0 += 8) {
                v2u cds[8]; f32x4 cdc[8];
#pragma unroll
                for (int i = 0; i < 8; ++i) { cds[i] = ds[i]; cdc[i] = dc[i]; }
                if (n0 + 8 < NCH) SCAN_LOAD(n0 + 8);
#pragma unroll
                for (int i = 0; i < 8; ++i) { *(v2u*)(ssp + (size_t)(n0 + i) * 65536) = (v2u){pk2(S[0], S[1]), pk2(S[2], S[3])};
                    const f32x4 dv = {bflo(cds[i].x), bfhi(cds[i].x), bflo(cds[i].y), bfhi(cds[i].y)}; S = S * cdc[i] + dv; }
            }
#undef SCAN_LOAD
        }
        float* so = a.out + O_SHP + ((size_t)(b * 4 + h) * 128 + d4) * 128 + v;
        so[0] = S[0]; so[128] = S[1]; so[256] = S[2]; so[384] = S[3];
    }
}

__device__ __forceinline__ void ointer_item(const Args& a, int item, int lane, int wave) {
    unsigned char* ws = a.ws; const bf16* QD = (const bf16*)(ws + WS_QD); const bf16* SST = (const bf16*)(ws + WS_SST); const bf16* OI = (const bf16*)(ws + WS_OI); const bf16* G = (const bf16*)(ws + WS_G); bf16* YM = (bf16*)(ws + WS_YM);
    const int bn = item >> 1, h = (item & 1) * 2 + (wave >> 2), tt = wave & 3, fr = lane & 15, fq = lane >> 4;
    const int row = bn * 64 + 16 * tt + fr; const size_t hb = (size_t)row * 512 + h * 128;
    bf16x8 fb[4];
#pragma unroll
    for (int ks = 0; ks < 4; ++ks) fb[ks] = __builtin_nontemporal_load((const bf16x8*)(QD + hb + 32 * ks + 8 * fq));
    const bf16* Sb = SST + ((size_t)bn * 4 + h) * 16384;
    bf16x8 fa[8][4]; v2u oi[8], gg[8];
#pragma unroll
    for (int vt = 0; vt < 8; ++vt) {
#pragma unroll
        for (int ks = 0; ks < 4; ++ks) fa[vt][ks] = *(const bf16x8*)(Sb + (size_t)(16 * vt + fr) * 128 + 32 * ks + 8 * fq);
        oi[vt] = __builtin_nontemporal_load((const v2u*)(OI + hb + 16 * vt + 4 * fq)); gg[vt] = __builtin_nontemporal_load((const v2u*)(G + hb + 16 * vt + 4 * fq)); }
    __builtin_amdgcn_sched_barrier(0);
    f32x4 o[8]; float ss = 0.f;
#pragma unroll
    for (int vt = 0; vt < 8; ++vt) { f32x4 acc = {bflo(oi[vt].x), bfhi(oi[vt].x), bflo(oi[vt].y), bfhi(oi[vt].y)};
#pragma unroll
        for (int ks = 0; ks < 4; ++ks) acc = __builtin_amdgcn_mfma_f32_16x16x32_bf16(fa[vt][ks], fb[ks], acc, 0, 0, 0);
        ss += (acc[0] * acc[0] + acc[1] * acc[1]) + (acc[2] * acc[2] + acc[3] * acc[3]); o[vt] = acc; }
    ss += __shfl_xor(ss, 16); ss += __shfl_xor(ss, 32);
    const float rstd = __builtin_amdgcn_rsqf(ss * (1.0f / 128.0f) + EPS);
    f32x4 ogv[8];
#pragma unroll
    for (int vt = 0; vt < 8; ++vt) ogv[vt] = *(const f32x4*)(a.hg_onorm_g + 16 * vt + 4 * fq);
    __builtin_amdgcn_sched_barrier(0);
#pragma unroll
    for (int vt = 0; vt < 8; ++vt) { const f32x4 og = ogv[vt];
        const float y0 = o[vt][0] * rstd * og[0] * bflo(gg[vt].x), y1 = o[vt][1] * rstd * og[1] * bfhi(gg[vt].x), y2 = o[vt][2] * rstd * og[2] * bflo(gg[vt].y), y3 = o[vt][3] * rstd * og[3] * bfhi(gg[vt].y);
        *(v2u*)(YM + (size_t)row * 1024 + h * 128 + 16 * vt + 4 * fq) = (v2u){pk2(y0, y1), pk2(y2, y3)}; }
}

__device__ __forceinline__ void final_norm(const Args& a, int lane, int wave, int m_first) {
    const float* SS3 = (const float*)(a.ws + OFF_SS3);
    f32x4 g[4];
#pragma unroll
    for (int j = 0; j < 4; ++j) g[j] = ((const f32x4*)a.final_g)[lane + 64 * j];
    for (int m = m_first + blockIdx.x * NWAVES + wave; m < ROWS_REAL + NSAMP; m += gridDim.x * NWAVES) {
        f32x4* p = (f32x4*)(a.out + (size_t)m * D) + lane;
        if (m < ROWS_REAL) {
            const float rs = __builtin_amdgcn_rsqf(SS3[m] * (1.0f / D) + EPS);
#pragma unroll
            for (int j = 0; j < 4; ++j) p[64 * j] = p[64 * j] * rs * g[j];
        } else {
            const f32x4* h1 = (const f32x4*)((const float*)(a.ws + WS_H1S) + (size_t)(ROW_SAMP - ROW_META + m - ROWS_REAL) * D) + lane; const f32x4* ac = (const f32x4*)((const float*)(a.ws + WS_ACC) + (size_t)(m - ROWS_REAL) * D) + lane;
            f32x4 v[4]; float s = 0.f;
#pragma unroll
            for (int j = 0; j < 4; ++j) { v[j] = h1[64 * j] + ac[64 * j]; s += (v[j].x * v[j].x + v[j].y * v[j].y) + (v[j].z * v[j].z + v[j].w * v[j].w); }
            const float rs = __builtin_amdgcn_rsqf(wave_sum(s) * (1.0f / D) + EPS);
#pragma unroll
            for (int j = 0; j < 4; ++j) p[64 * j] = v[j] * rs * g[j];
        }
    }
}

__global__ void __launch_bounds__(NTHR, 2) hymba_fwd(Args args) {
    extern __shared__ __attribute__((aligned(16))) unsigned char lds_raw[];
    LAS unsigned char* lds = (LAS unsigned char*)lds_raw;
    const int tid = threadIdx.x, lane = tid & 63, wave = __builtin_amdgcn_readfirstlane(tid >> 6);
    const int G = gridDim.x, bx = blockIdx.x;
    unsigned char* ws = args.ws;
    const int lo = args.ph_lo, hi = args.ph_hi;
#ifndef PHMASK
#define PHMASK 0x1ff
#endif
#define IN(k) (((PHMASK >> (k)) & 1) && lo <= (k) && (k) < hi)
#ifndef PROBE_BLK
#define PROBE_BLK 0
#endif
#ifndef PROBE_A
#define PROBE_A 0
#define PROBE_B 0
#endif
    unsigned long long ts_a = 0, ts_b = 0;
#define STAMP(i) do { if (PROBE_B > PROBE_A) { if ((i) == PROBE_A) ts_a = __builtin_amdgcn_s_memrealtime(); if ((i) == PROBE_B) ts_b = __builtin_amdgcn_s_memrealtime(); } } while (0)
    STAMP(0);
    volatile LAS unsigned* bar_st = (volatile LAS unsigned*)(lds + LDS_BYTES - 64);
    if (tid < 2) bar_st[tid] = 0u;
    __syncthreads();
    XcdBarrier xbar; xbar.bar = (unsigned*)(ws + OFF_BAR); xbar.x = 0; xbar.st = bar_st;
    if (args.coop) xbar = xcd_barrier_post((unsigned*)(ws + OFF_BAR), bar_st);
    if (args.coop == 2) cg::this_grid().sync();
#define SEAM(k) do { if (IN(k) && IN((k) + 1)) { xcd_barrier(xbar); } STAMP((k) + 1); } while (0)
    if (IN(0)) { p0_prologue(args, lds, tid, lane, wave); }
    SEAM(0);
    if (IN(1)) {
        pg8::Gemm g{(const pg8::bf16_t*)(ws + WS_XB), (const pg8::bf16_t*)(ws + WS_WIN), MROWS, NIN, D}; pg8::StaticOrder S; S.init(ROWS_REAL, NIN, G, bx);
        pg8::EpiIn E{(bf16*)(ws + WS_Q), (bf16*)(ws + WS_V), (bf16*)(ws + WS_G), (bf16*)(ws + WS_GLU), (float*)(ws + WS_LF), (const float*)(ws + OFF_RS1), (const float*)(ws + OFF_LB)};
        pg8::gemm_phase<pg8::EpiIn, pg8::StaticOrder, true, true>(lds, g, S, E);
        for (int u = bx; u < 192; u += G) skinny_in(args, lds, u, lane, wave);
    }
    SEAM(1);
    if (IN(2)) {
#ifndef P2SEL
#define P2SEL 7
#endif
        if ((P2SEL & 2) && bx < 256) conv_item(args, lds, bx, tid, lane, wave);
        STAMP(10);
        if (P2SEL & 1) { ChunkIn cin; int it = bx; if (it < 1028) chunk_load(args, it, tid, cin);
            while (it < 1028) { ChunkIn cur = cin; const int nx = it + G; if (nx < 1028) chunk_load(args, nx, tid, cin); hgrn_chunk_item(args, lds, it, cur, tid, lane, wave); it = nx; } }
        STAMP(11);
        if (P2SEL & 4) { const bool has_sc = bx >= 128 && bx - 128 < NSAMP; SConvIn sci;
            if (has_sc) sample_conv_load(args, bx - 128, tid, sci);
            const bool reb = (G == 256); const int n_s = reb ? (bx < 4 ? 1 : (bx < 8 ? 3 : 2)) : (1 << 30);
            SampIn sin; int it = bx, k = 0; if (it < 4 * NSAMP) samp_load(args, it, tid, sin);
            while (it < 4 * NSAMP && k < n_s) { SampIn cur = sin; const int nx = (reb && k == 1) ? bx + 252 : it + G; if (k + 1 < n_s && nx < 4 * NSAMP) samp_load(args, nx, tid, sin); samp_item(args, lds, it, cur, tid, lane, wave); it = nx; ++k; }
            if (has_sc) sample_conv_item(args, lds, bx - 128, sci, tid, lane, wave); }
        STAMP(12);
    }
    SEAM(2);
    if (IN(3)) { scan_phase(args, tid); }
    SEAM(3);
    if (IN(4)) {
        for (int it0 = bx; it0 < NB * NCH * 2; it0 += 2 * G) { ointer_item(args, it0, lane, wave); if (it0 + G < NB * NCH * 2) ointer_item(args, it0 + G, lane, wave); }
        for (int u = bx; u < 256; u += G) skinny_out(args, lds, u, lane, wave);
    }
    SEAM(4);
    if (IN(5)) {
        pg8::Gemm g{(const pg8::bf16_t*)(ws + WS_YM), (const pg8::bf16_t*)(ws + WS_WOUT), MROWS, D, D}; pg8::StaticOrder S; S.init(ROWS_REAL, D, G, bx);
        pg8::EpiOut E{args.x_prompt, args.meta, args.x_sample, (bf16*)(ws + WS_HB), (float*)(ws + OFF_SS2)};
        pg8::gemm_phase<pg8::EpiOut, pg8::StaticOrder, true, true>(lds, g, S, E);
        for (int u = bx; u < 256; u += G) skinny_up(args, lds, u, lane, wave);
    }
    SEAM(5);
    if (IN(6)) {
        pg8::Gemm g{(const pg8::bf16_t*)(ws + WS_HB), (const pg8::bf16_t*)(ws + WS_WUP), MROWS, FF, D}; pg8::StaticOrder S; S.init(ROWS_REAL, FF, G, bx);
        pg8::EpiUp E{(bf16*)(ws + WS_HID), (const float*)(ws + OFF_SS2)};
        pg8::gemm_phase<pg8::EpiUp, pg8::StaticOrder, true, true>(lds, g, S, E);
        for (int u = bx; u < 256; u += G) skinny_down(args, lds, u, lane, wave);
    }
    SEAM(6);
    if (IN(7)) {
        if (G == 256) final_norm(args, lane, wave, ROWS_REAL);
        pg8::Gemm g{(const pg8::bf16_t*)(ws + WS_HID), (const pg8::bf16_t*)(ws + WS_WDN), MROWS, D, FF}; pg8::StaticOrder S; S.init(ROWS_REAL, D, G, bx);
        if (G == 256) { pg8::EpiDownF E{(const bf16*)(ws + WS_HB), args.out + O_YP, (float*)(ws + OFF_SS3), (unsigned*)(ws + OFF_CNT), args.final_g};
            pg8::gemm_phase<pg8::EpiDownF, pg8::StaticOrder, false, true>(lds, g, S, E); }
        else { pg8::EpiDown E{(const bf16*)(ws + WS_HB), args.out + O_YP, args.out + O_YS, (float*)(ws + OFF_SS3)};
            pg8::gemm_phase<pg8::EpiDown, pg8::StaticOrder, true, true>(lds, g, S, E); }
    }
    if (G != 256) { SEAM(7); if (IN(8)) { final_norm(args, lane, wave, 0); } }
    if (PROBE_B > PROBE_A) { STAMP(9); if (bx == PROBE_BLK && tid == 0) { const unsigned long long t0 = __builtin_amdgcn_s_memrealtime(), want = 4ull * (ts_b - ts_a); while (__builtin_amdgcn_s_memrealtime() - t0 < want) __builtin_amdgcn_s_sleep(8); } }
#undef IN
#undef SEAM
}

#ifndef N_LAUNCH_MODE
#define N_LAUNCH_MODE 1
#endif
extern "C" void kernel_launch(void* const* d_in, const int* in_sizes, int n_in, void* d_out, int out_size, void* d_ws, size_t ws_size, hipStream_t stream) {
    static int grid = 0;
    if (grid == 0) {
        int dev = 0, cus = 0, per_cu = 0;
        hipGetDevice(&dev); hipDeviceGetAttribute(&cus, hipDeviceAttributeMultiprocessorCount, dev);
        hipFuncSetAttribute((const void*)hymba_fwd, hipFuncAttributeMaxDynamicSharedMemorySize, LDS_BYTES);
        hipOccupancyMaxActiveBlocksPerMultiprocessor(&per_cu, (const void*)hymba_fwd, NTHR, LDS_BYTES);
        if (per_cu < 1) per_cu = 1;
        grid = cus * per_cu;
        if (ws_size < WS_END || n_in != 18) { fprintf(stderr, "kernel_launch: ws %zu < %zu or n_in %d\n", ws_size, (size_t)WS_END, n_in); }
        fprintf(stderr, "kernel_launch: grid %d (cus %d x %d)\n", grid, cus, per_cu);
    }
    Args a{};
    const float** pp = (const float**)&a;
    for (int i = 0; i < 18; ++i) pp[i] = (const float*)d_in[i];
    a.out = (float*)d_out; a.ws = (unsigned char*)d_ws; a.pad = 0;
#if N_LAUNCH_MODE == 1
    a.ph_lo = 0; a.ph_hi = 9; a.coop = 1;
    hipMemsetAsync((char*)d_ws + OFF_BAR, 0, BAR_BYTES, stream);
    void* kargs[] = {&a};
    hipError_t e = hipLaunchCooperativeKernel((const void*)hymba_fwd, dim3(grid), dim3(NTHR), kargs, LDS_BYTES, stream);
    if (e != hipSuccess) fprintf(stderr, "cooperative launch failed: %s (grid %d)\n", hipGetErrorString(e), grid);
#else
#ifndef DUP_MASK
#define DUP_MASK 0
#endif
    for (int p = 0; p < 9; ++p) for (int r = 0; r < 1 + ((DUP_MASK >> p) & 1); ++r) { a.ph_lo = p; a.ph_hi = p + 1; a.coop = 0; hipLaunchKernelGGL(hymba_fwd, dim3(grid), dim3(NTHR), LDS_BYTES, stream, a); }
#endif
}
```

```cpp
#include <hip/hip_runtime.h>
#include <hip/hip_cooperative_groups.h>
#include <cstdio>
#include <cstdint>
namespace cg = cooperative_groups;
namespace pg8 {
#define PG8_LAS __attribute__((address_space(3)))
typedef unsigned short bf16_t;
typedef short bf16x8 __attribute__((ext_vector_type(8)));
typedef float f32x4 __attribute__((ext_vector_type(4)));
typedef unsigned u32x4 __attribute__((ext_vector_type(4)));
constexpr int BM = 256, BK = 64, HALF = 128, HTB = HALF * BK * 2  , STAGE_BYTES = 8 * HTB, NXCD = 8, WGM = 8;

__host__ __device__ __forceinline__ int lds_byte(int r, int c) { const int st = (r >> 4) * 2 + (c >> 5), rr = r & 15, cc = c & 31, ob = rr * 64 + cc * 2; return st * 1024 + (ob ^ (((ob >> 9) & 1) << 5)); }
__host__ __device__ __forceinline__ void stage_rc(int b, int& R, int& C) { const int st = b / 1024, sb = b % 1024, swz = sb ^ (((sb >> 9) & 1) << 5); R = (st >> 1) * 16 + swz / 64; C = (st & 1) * 32 + (swz % 64) / 2; }
__host__ __device__ __forceinline__ int perm32(int rho) { const int n = rho >> 4, i = rho & 15; return 8 * (i >> 2) + 4 * n + (i & 3); }

struct Unit { int pm, pn; };
struct Gemm { const bf16_t* A; const bf16_t* Bt; int M, N, K; };

struct StaticOrder {
    int nM, nN, nwg, G, c;
    __host__ __device__ void init(int M, int N, int G_, int c_) { nM = M / BM; nN = N / BM; nwg = nM * nN; G = G_; c = c_; }
    __host__ __device__ bool next(int i, Unit& u) const {
        const long L = (long)i * G + c; if (L >= nwg) return false;
        int wgid = (int)L; { const int q = nwg / NXCD, r = nwg % NXCD, xcd = wgid % NXCD, off = wgid / NXCD; wgid = (xcd < r ? xcd * (q + 1) : r * (q + 1) + (xcd - r) * q) + off; }
        const int nig = WGM * nN, gid = wgid / nig, fm = gid * WGM, gsz = (nM - fm) < WGM ? (nM - fm) : WGM;
        u.pm = fm + ((wgid % nig) % gsz); u.pn = (wgid % nig) / gsz; return true;
    }
    __device__ __forceinline__ void a_ready(const Unit&) const {}
    __device__ __forceinline__ void done(const Unit&) const {}
};

typedef __bf16 hw_bf16x2 __attribute__((ext_vector_type(2)));
typedef float hw_f32x2 __attribute__((ext_vector_type(2)));
__device__ __forceinline__ unsigned cvt_pk_bf16(float lo, float hi) { const hw_f32x2 v = {lo, hi}; return __builtin_bit_cast(unsigned, __builtin_convertvector(v, hw_bf16x2)); }
typedef float f32x2 __attribute__((ext_vector_type(2)));
constexpr int ROWS_REAL = 16384, ROW_META = 16384, ROW_SAMP = 16400, ROWS_USED = 16528, MROWS = 16640;
__device__ __forceinline__ float sigm(float x) { return __builtin_amdgcn_rcpf(1.0f + __expf(-x)); }
__device__ __forceinline__ float silu_f(float x) { return x * sigm(x); }
__device__ __forceinline__ u32x4 pack8(const f32x4 a, const f32x4 b) { u32x4 w; w.x = cvt_pk_bf16(a[0], a[1]); w.y = cvt_pk_bf16(a[2], a[3]); w.z = cvt_pk_bf16(b[0], b[1]); w.w = cvt_pk_bf16(b[2], b[3]); return w; }

struct EpiIn {
    static constexpr bool PERM = true, AFTER_DRAIN = false;
    bf16_t *Q, *V, *G, *GLU; float* LF; const float* rs1; const float* LB;
    __device__ __forceinline__ void operator()(const f32x4 (&acc)[2][2][4][2], const Unit& u, int wr, int wc, int fr, int fq) const {
        const int row0 = u.pm * BM + wr * 64 + fr; const int pn = u.pn;
        float rsv[2][4];
#pragma unroll
        for (int ai = 0; ai < 2; ++ai)
#pragma unroll
            for (int m = 0; m < 4; ++m) rsv[ai][m] = rs1[row0 + ai * HALF + m * 16];
        if (pn < 8) {
            const int type = pn >> 1; const int colb = (pn & 1) * 256 + wc * 32 + 8 * fq;
            f32x4 lb[2][2];
            if (type == 1) {
#pragma unroll
                for (int bj = 0; bj < 2; ++bj)
#pragma unroll
                    for (int n = 0; n < 2; ++n) lb[bj][n] = *(const f32x4*)(LB + colb + bj * HALF + 4 * n);
            }
#pragma unroll
            for (int ai = 0; ai < 2; ++ai)
#pragma unroll
                for (int m = 0; m < 4; ++m) { const int row = row0 + ai * HALF + m * 16; const float rs = rsv[ai][m];
#pragma unroll
                    for (int bj = 0; bj < 2; ++bj) { f32x4 v0 = acc[ai][bj][m][0] * rs, v1 = acc[ai][bj][m][1] * rs; const size_t off = (size_t)row * 512 + colb + bj * HALF;
                        if (type == 1) {
#pragma unroll
                            for (int i = 0; i < 4; ++i) { const float l0 = lb[bj][0][i], l1 = lb[bj][1][i];
                                v0[i] = __logf(l0 + (1.0f - l0) * sigm(v0[i])); v1[i] = __logf(l1 + (1.0f - l1) * sigm(v1[i])); }
                            *(f32x4*)(LF + off) = v0; *(f32x4*)(LF + off + 4) = v1;
                        } else {
                            if (type != 2) {
#pragma unroll
                                for (int i = 0; i < 4; ++i) { v0[i] = silu_f(v0[i]); v1[i] = silu_f(v1[i]); } }
                            const int sel = (type == 0) ? 0 : (type == 2 ? 1 : 3);
                            bf16_t* dst = Q + (size_t)sel * ((size_t)MROWS * 512);
                            *(u32x4*)(dst + off) = pack8(v0, v1);
                        } } }
        } else {
            const int colb = (pn - 8) * 128 + wc * 32 + 8 * fq;
#pragma unroll
            for (int ai = 0; ai < 2; ++ai)
#pragma unroll
                for (int m = 0; m < 4; ++m) { const int row = row0 + ai * HALF + m * 16; const float rs = rsv[ai][m];
                    f32x4 g0, g1;
#pragma unroll
                    for (int i = 0; i < 4; ++i) { g0[i] = acc[ai][0][m][0][i] * rs * sigm(acc[ai][1][m][0][i] * rs); g1[i] = acc[ai][0][m][1][i] * rs * sigm(acc[ai][1][m][1][i] * rs); }
                    *(u32x4*)(GLU + (size_t)row * 512 + colb) = pack8(g0, g1); }
        }
    }
};
__device__ __forceinline__ const float* resid_row(const float* xp, const float* meta, const float* xs, int row) {
    return row < ROWS_REAL ? xp + (size_t)row * 1024 : (row < ROW_SAMP ? meta + (size_t)(row - ROW_META) * 1024 : (row < ROWS_USED ? xs + (size_t)(row - ROW_SAMP) * 1024 : nullptr));
}
struct EpiOut {
    static constexpr bool PERM = true, AFTER_DRAIN = false;
    const float *xp, *meta, *xs; bf16_t* HB; float* SS;
    __device__ __forceinline__ void operator()(const f32x4 (&acc)[2][2][4][2], const Unit& u, int wr, int wc, int fr, int fq) const {
        const int row0 = u.pm * BM + wr * 64 + fr; const int colb = u.pn * BM + wc * 32 + 8 * fq;
#pragma unroll
        for (int ai = 0; ai < 2; ++ai) {
            f32x4 rv[4][2][2];
#pragma unroll
            for (int m = 0; m < 4; ++m) { const int row = row0 + ai * HALF + m * 16; const float* rp = resid_row(xp, meta, xs, row);
#pragma unroll
                for (int bj = 0; bj < 2; ++bj) { const int col = colb + bj * HALF;
                    rv[m][bj][0] = rp ? __builtin_nontemporal_load((const f32x4*)(rp + col)) : (f32x4){0.f, 0.f, 0.f, 0.f}; rv[m][bj][1] = rp ? __builtin_nontemporal_load((const f32x4*)(rp + col + 4)) : (f32x4){0.f, 0.f, 0.f, 0.f}; } }
#pragma unroll
            for (int m = 0; m < 4; ++m) { const int row = row0 + ai * HALF + m * 16; float ss = 0.f;
#pragma unroll
                for (int bj = 0; bj < 2; ++bj) { const int col = colb + bj * HALF; const f32x4 v0 = acc[ai][bj][m][0] + rv[m][bj][0], v1 = acc[ai][bj][m][1] + rv[m][bj][1];
                    ss += (v0[0] * v0[0] + v0[1] * v0[1]) + (v0[2] * v0[2] + v0[3] * v0[3]) + (v1[0] * v1[0] + v1[1] * v1[1]) + (v1[2] * v1[2] + v1[3] * v1[3]);
                    *(u32x4*)(HB + (size_t)row * 1024 + col) = pack8(v0, v1); }
                ss += __shfl_xor(ss, 16); ss += __shfl_xor(ss, 32);
                if (fq == 0) atomicAdd(SS + row, ss); }
        }
    }
};
struct EpiUp {
    static constexpr bool PERM = true, AFTER_DRAIN = false;
    bf16_t* HID; const float* SS;
    __device__ __forceinline__ void operator()(const f32x4 (&acc)[2][2][4][2], const Unit& u, int wr, int wc, int fr, int fq) const {
        const int row0 = u.pm * BM + wr * 64 + fr; const int colb = u.pn * BM + wc * 32 + 8 * fq;
        float ssv[2][4];
#pragma unroll
        for (int ai = 0; ai < 2; ++ai)
#pragma unroll
            for (int m = 0; m < 4; ++m) ssv[ai][m] = SS[row0 + ai * HALF + m * 16];
#pragma unroll
        for (int ai = 0; ai < 2; ++ai)
#pragma unroll
            for (int m = 0; m < 4; ++m) { const int row = row0 + ai * HALF + m * 16; const float rs = __builtin_amdgcn_rsqf(ssv[ai][m] * (1.0f / 1024.0f) + 1e-6f);
#pragma unroll
                for (int bj = 0; bj < 2; ++bj) { f32x4 v0 = acc[ai][bj][m][0] * rs, v1 = acc[ai][bj][m][1] * rs;
#pragma unroll
                    for (int i = 0; i < 4; ++i) { const float a = fmaxf(v0[i], 0.f), b = fmaxf(v1[i], 0.f); v0[i] = a * a; v1[i] = b * b; }
                    *(u32x4*)(HID + (size_t)row * 4096 + colb + bj * HALF) = pack8(v0, v1); } }
    }
};
struct EpiDown {
    static constexpr bool PERM = true, AFTER_DRAIN = false;
    const bf16_t* HB; float* yp; float* ys; float* SS;
    __device__ __forceinline__ void operator()(const f32x4 (&acc)[2][2][4][2], const Unit& u, int wr, int wc, int fr, int fq) const {
        const int row0 = u.pm * BM + wr * 64 + fr; const int colb = u.pn * BM + wc * 32 + 8 * fq;
#pragma unroll
        for (int ai = 0; ai < 2; ++ai)
#pragma unroll
            for (int m = 0; m < 4; ++m) { const int row = row0 + ai * HALF + m * 16;
                float* op = row < ROWS_REAL ? yp + (size_t)row * 1024 : ((row >= ROW_SAMP && row < ROWS_USED) ? ys + (size_t)(row - ROW_SAMP) * 1024 : nullptr);
                if (op) { float ss = 0.f;
#pragma unroll
                    for (int bj = 0; bj < 2; ++bj) { const int col = colb + bj * HALF; const size_t off = (size_t)row * 1024 + col;
                        const u32x4 hb = *(const u32x4*)(HB + off);
                        const f32x4 v0 = acc[ai][bj][m][0] + (f32x4){__builtin_bit_cast(float, hb.x << 16), __builtin_bit_cast(float, hb.x & 0xffff0000u), __builtin_bit_cast(float, hb.y << 16), __builtin_bit_cast(float, hb.y & 0xffff0000u)},
                                    v1 = acc[ai][bj][m][1] + (f32x4){__builtin_bit_cast(float, hb.z << 16), __builtin_bit_cast(float, hb.z & 0xffff0000u), __builtin_bit_cast(float, hb.w << 16), __builtin_bit_cast(float, hb.w & 0xffff0000u)};
                        ss += (v0[0] * v0[0] + v0[1] * v0[1]) + (v0[2] * v0[2] + v0[3] * v0[3]) + (v1[0] * v1[0] + v1[1] * v1[1]) + (v1[2] * v1[2] + v1[3] * v1[3]);
                        *(f32x4*)(op + col) = v0; *(f32x4*)(op + col + 4) = v1; }
                    ss += __shfl_xor(ss, 16); ss += __shfl_xor(ss, 32);
                    if (fq == 0) atomicAdd(SS + row, ss); } }
    }
};
struct EpiDownF {
    static constexpr bool PERM = true, AFTER_DRAIN = true;
    const bf16_t* HB; float* yp; float* SS; unsigned* cnt; const float* fg;
    __device__ __forceinline__ void fused(f32x4 (&acc)[2][2][4][2], const Unit& u, int wr, int wc, int fr, int fq, PG8_LAS unsigned char* lds, int wid, int lane) const {
        const int row0 = u.pm * BM + wr * 64 + fr; const int colb = u.pn * BM + wc * 32 + 8 * fq;
#pragma unroll
        for (int ai = 0; ai < 2; ++ai) {
            u32x4 hbv[4][2];
#pragma unroll
            for (int m = 0; m < 4; ++m)
#pragma unroll
                for (int bj = 0; bj < 2; ++bj) hbv[m][bj] = __builtin_nontemporal_load((const u32x4*)(HB + (size_t)(row0 + ai * HALF + m * 16) * 1024 + colb + bj * HALF));
#pragma unroll
            for (int m = 0; m < 4; ++m) { const int row = row0 + ai * HALF + m * 16; float ss = 0.f;
#pragma unroll
                for (int bj = 0; bj < 2; ++bj) { const u32x4 hb = hbv[m][bj];
                    const f32x4 v0 = acc[ai][bj][m][0] + (f32x4){__builtin_bit_cast(float, hb.x << 16), __builtin_bit_cast(float, hb.x & 0xffff0000u), __builtin_bit_cast(float, hb.y << 16), __builtin_bit_cast(float, hb.y & 0xffff0000u)},
                                v1 = acc[ai][bj][m][1] + (f32x4){__builtin_bit_cast(float, hb.z << 16), __builtin_bit_cast(float, hb.z & 0xffff0000u), __builtin_bit_cast(float, hb.w << 16), __builtin_bit_cast(float, hb.w & 0xffff0000u)};
                    ss += (v0[0] * v0[0] + v0[1] * v0[1]) + (v0[2] * v0[2] + v0[3] * v0[3]) + (v1[0] * v1[0] + v1[1] * v1[1]) + (v1[2] * v1[2] + v1[3] * v1[3]);
                    acc[ai][bj][m][0] = v0; acc[ai][bj][m][1] = v1; }
                ss += __shfl_xor(ss, 16); ss += __shfl_xor(ss, 32);
                if (fq == 0) atomicAdd(SS + row, ss); }
        }
        asm volatile("s_waitcnt vmcnt(0)" ::: "memory");
        unsigned* c = cnt + 64 * u.pm;
        if (lane == 0) __hip_atomic_fetch_add(c, 1u, __ATOMIC_RELEASE, __HIP_MEMORY_SCOPE_AGENT);
        if (wid == 0) { unsigned sp = 0;
            while ((unsigned)__builtin_amdgcn_readfirstlane(__hip_atomic_load(c, __ATOMIC_RELAXED, __HIP_MEMORY_SCOPE_AGENT)) < 32u) { __builtin_amdgcn_s_sleep(2); if (++sp > (1u << 22)) break; }
            __builtin_amdgcn_fence(__ATOMIC_ACQUIRE, "agent"); }
        asm volatile("s_waitcnt vmcnt(0) lgkmcnt(0)" ::: "memory"); __builtin_amdgcn_s_barrier(); asm volatile("" ::: "memory");
        f32x4 g[2][2];
#pragma unroll
        for (int bj = 0; bj < 2; ++bj) { g[bj][0] = *(const f32x4*)(fg + colb + bj * HALF); g[bj][1] = *(const f32x4*)(fg + colb + bj * HALF + 4); }
        float ssv[2][4];
#pragma unroll
        for (int ai = 0; ai < 2; ++ai)
#pragma unroll
            for (int m = 0; m < 4; ++m) ssv[ai][m] = __hip_atomic_load(SS + row0 + ai * HALF + m * 16, __ATOMIC_RELAXED, __HIP_MEMORY_SCOPE_AGENT);
#pragma unroll
        for (int ai = 0; ai < 2; ++ai)
#pragma unroll
            for (int m = 0; m < 4; ++m) { const int row = row0 + ai * HALF + m * 16;
                const float rs = __builtin_amdgcn_rsqf(ssv[ai][m] * (1.0f / 1024.0f) + 1e-6f);
#pragma unroll
                for (int bj = 0; bj < 2; ++bj) { float* op = yp + (size_t)row * 1024 + colb + bj * HALF;
                    *(f32x4*)op = acc[ai][bj][m][0] * rs * g[bj][0]; *(f32x4*)(op + 4) = acc[ai][bj][m][1] * rs * g[bj][1]; } }
    }
};
template <class Epi, class Sched, bool ALIGN_EPI = false, bool SP2 = false>
__device__ __forceinline__ void gemm_phase(PG8_LAS unsigned char* lds, const Gemm g, const Sched& S, const Epi& E) {
    const int tid = threadIdx.x, wid = __builtin_amdgcn_readfirstlane(tid >> 6), lane = tid & 63, wr = wid >> 2, wc = wid & 3, fr = lane & 15, fq = lane >> 4;
    const int K = g.K, nt = K / BK;
    unsigned voffA[2], voffB[2];
#pragma unroll
    for (int i = 0; i < 2; ++i) { int R, C; stage_rc(tid * 16 + i * 8192, R, C); const int Rb = Epi::PERM ? ((R & ~31) + perm32(R & 31)) : R;
        voffA[i] = (unsigned)(R * K + C) * 2u; voffB[i] = (unsigned)(Rb * K + C) * 2u; }
    const size_t kstep = (size_t)(BK * 2);
    const size_t hstep = (size_t)HALF * K * 2;
    const size_t tstep = 2 * hstep;
    const unsigned ldsw = (unsigned)wid * 1024u;
    const int aoff = lds_byte(wr * 64 + fr, fq * 8), boff = lds_byte(wc * 32 + fr, fq * 8);
#define PG8_SA(b, h) (((b) * 2 + (h)) * HTB)
#define PG8_SB(b, h) ((4 + (b) * 2 + (h)) * HTB)
#define PG8_STAGE(bufoff, gbase, voff) do { _Pragma("unroll") for (int _i = 0; _i < 2; ++_i) \
        __builtin_amdgcn_global_load_lds((const unsigned*)((const char*)(gbase) + (voff)[_i]), (PG8_LAS unsigned*)(lds + (bufoff) + ldsw + _i * 8192), 16, 0, 0); } while (0)
#define PG8_LDA(dst, b, h) do { _Pragma("unroll") for (int m = 0; m < 4; ++m) _Pragma("unroll") for (int k = 0; k < 2; ++k) dst[m][k] = *(const PG8_LAS bf16x8*)(lds + PG8_SA(b, h) + aoff + m * 2048 + k * 1024); } while (0)
#define PG8_LDB(dst, b, h) do { _Pragma("unroll") for (int n = 0; n < 2; ++n) _Pragma("unroll") for (int k = 0; k < 2; ++k) dst[n][k] = *(const PG8_LAS bf16x8*)(lds + PG8_SB(b, h) + boff + n * 2048 + k * 1024); } while (0)
#define PG8_MMA(ai, bj, At, Bt) do { __builtin_amdgcn_s_setprio(1); _Pragma("unroll") for (int m = 0; m < 4; ++m) _Pragma("unroll") for (int n = 0; n < 2; ++n) _Pragma("unroll") for (int k = 0; k < 2; ++k) \
        acc[ai][bj][m][n] = __builtin_amdgcn_mfma_f32_16x16x32_bf16(Bt[n][k], At[m][k], acc[ai][bj][m][n], 0, 0, 0); __builtin_amdgcn_s_setprio(0); } while (0)
#define PG8_WAIT_V(n) asm volatile("s_waitcnt vmcnt(" #n ")" ::: "memory")
#define PG8_WAIT_L(n) asm volatile("s_waitcnt lgkmcnt(" #n ")" ::: "memory")
#define PG8_BAR __builtin_amdgcn_s_barrier()
#define PG8_SCHED __builtin_amdgcn_sched_barrier(0)
    Unit cur, nxt; int ui = 0;
    if (!S.next(0, cur)) return;
    f32x4 acc[2][2][4][2];
#pragma unroll
    for (int a = 0; a < 2; ++a)
#pragma unroll
        for (int b = 0; b < 2; ++b)
#pragma unroll
            for (int m = 0; m < 4; ++m)
#pragma unroll
                for (int n = 0; n < 2; ++n) acc[a][b][m][n] = (f32x4){0.f, 0.f, 0.f, 0.f};
    bf16x8 At[4][2], B0[2][2], B1[2][2];
    const char* cA = (const char*)g.A + (size_t)cur.pm * tstep; const char* cB = (const char*)g.Bt + (size_t)cur.pn * tstep;
    S.a_ready(cur);
    if constexpr (SP2) {
        PG8_STAGE(PG8_SB(0, 0), cB, voffB); PG8_STAGE(PG8_SB(0, 1), cB + hstep, voffB); PG8_STAGE(PG8_SA(0, 0), cA, voffA); PG8_STAGE(PG8_SA(0, 1), cA + hstep, voffA);
        if (wr == 1) PG8_BAR;
        PG8_WAIT_V(2); PG8_BAR;
        PG8_STAGE(PG8_SB(1, 0), cB + kstep, voffB); PG8_STAGE(PG8_SA(1, 0), cA + kstep, voffA); PG8_STAGE(PG8_SB(1, 1), cB + hstep + kstep, voffB);
        PG8_WAIT_V(6); PG8_BAR;
    } else {
        PG8_STAGE(PG8_SB(0, 0), cB, voffB); PG8_STAGE(PG8_SA(0, 0), cA, voffA); PG8_STAGE(PG8_SB(0, 1), cB + hstep, voffB); PG8_STAGE(PG8_SA(0, 1), cA + hstep, voffA);
        if (wr == 1) PG8_BAR;
        PG8_WAIT_V(4); PG8_BAR;
        PG8_STAGE(PG8_SB(1, 0), cB + kstep, voffB); PG8_STAGE(PG8_SA(1, 0), cA + kstep, voffA); PG8_STAGE(PG8_SB(1, 1), cB + hstep + kstep, voffB);
        PG8_WAIT_V(6); PG8_BAR;
    }
    for (;;) {
        const bool has_next = S.next(ui + 1, nxt);
        const char* nA = has_next ? (const char*)g.A + (size_t)nxt.pm * tstep : cA; const char* nB = has_next ? (const char*)g.Bt + (size_t)nxt.pn * tstep : cB;
        for (int t = 0; t < nt; t += 2) {
            const bool last = (t == nt - 2);
            const char* a1 = cA + (size_t)(t + 1) * kstep;
            const char* a2 = last ? nA : cA + (size_t)(t + 2) * kstep; const char* b2 = last ? nB : cB + (size_t)(t + 2) * kstep;
            const char* a3 = a2 + kstep; const char* b3 = b2 + kstep;
            if (last && has_next) S.a_ready(nxt);
            if constexpr (SP2) {
            PG8_LDB(B0, 0, 0); PG8_LDB(B1, 0, 1); PG8_SCHED; PG8_LDA(At, 0, 0); PG8_STAGE(PG8_SA(1, 1), a1 + hstep, voffA);
            PG8_WAIT_V(8); PG8_WAIT_L(0); PG8_BAR; PG8_MMA(0, 0, At, B0); PG8_MMA(0, 1, At, B1); PG8_BAR; PG8_SCHED;
            PG8_LDA(At, 0, 1); PG8_STAGE(PG8_SB(0, 0), b2, voffB); PG8_STAGE(PG8_SB(0, 1), b2 + hstep, voffB); PG8_STAGE(PG8_SA(0, 0), a2, voffA);
            PG8_WAIT_V(8); PG8_WAIT_L(0); PG8_BAR; PG8_MMA(1, 0, At, B0); PG8_MMA(1, 1, At, B1); PG8_BAR; PG8_SCHED;
            PG8_LDB(B0, 1, 0); PG8_LDB(B1, 1, 1); PG8_SCHED; PG8_LDA(At, 1, 0); PG8_STAGE(PG8_SA(0, 1), a2 + hstep, voffA);
            PG8_WAIT_V(8); PG8_WAIT_L(0); PG8_BAR; PG8_MMA(0, 0, At, B0); PG8_MMA(0, 1, At, B1); PG8_BAR; PG8_SCHED;
            PG8_LDA(At, 1, 1); PG8_STAGE(PG8_SB(1, 0), b3, voffB); PG8_STAGE(PG8_SB(1, 1), b3 + hstep, voffB); PG8_STAGE(PG8_SA(1, 0), a3, voffA);
            PG8_WAIT_V(8); PG8_WAIT_L(0); PG8_BAR; PG8_MMA(1, 0, At, B0); PG8_MMA(1, 1, At, B1); PG8_BAR; PG8_SCHED;
            } else {
            PG8_LDB(B0, 0, 0); PG8_SCHED; PG8_LDA(At, 0, 0); PG8_STAGE(PG8_SA(1, 1), a1 + hstep, voffA);
            PG8_WAIT_L(8); PG8_BAR; PG8_WAIT_L(0); PG8_MMA(0, 0, At, B0); PG8_BAR; PG8_SCHED;
            PG8_LDB(B1, 0, 1); PG8_STAGE(PG8_SB(0, 0), b2, voffB);
            PG8_BAR; PG8_WAIT_L(0); PG8_MMA(0, 1, At, B1); PG8_BAR;
            PG8_LDA(At, 0, 1); PG8_STAGE(PG8_SA(0, 0), a2, voffA);
            PG8_BAR; PG8_WAIT_L(0); PG8_MMA(1, 0, At, B0); PG8_BAR; PG8_SCHED;
            PG8_STAGE(PG8_SB(0, 1), b2 + hstep, voffB);
            PG8_WAIT_V(6); PG8_BAR; PG8_MMA(1, 1, At, B1); PG8_BAR;
            PG8_LDB(B0, 1, 0); PG8_SCHED; PG8_LDA(At, 1, 0); PG8_STAGE(PG8_SA(0, 1), a2 + hstep, voffA);
            PG8_WAIT_L(8); PG8_BAR; PG8_WAIT_L(0); PG8_MMA(0, 0, At, B0); PG8_BAR; PG8_SCHED;
            PG8_LDB(B1, 1, 1); PG8_STAGE(PG8_SB(1, 0), b3, voffB);
            PG8_BAR; PG8_WAIT_L(0); PG8_MMA(0, 1, At, B1); PG8_BAR;
            PG8_LDA(At, 1, 1); PG8_STAGE(PG8_SA(1, 0), a3, voffA);
            PG8_BAR; PG8_WAIT_L(0); PG8_MMA(1, 0, At, B0); PG8_BAR; PG8_SCHED;
            PG8_STAGE(PG8_SB(1, 1), b3 + hstep, voffB);
            PG8_WAIT_V(6); PG8_BAR; PG8_MMA(1, 1, At, B1); PG8_BAR;
            }
        }
        if constexpr (ALIGN_EPI) { if (wr == 0) PG8_BAR; }
        if constexpr (!Epi::AFTER_DRAIN) { E(acc, cur, wr, wc, fr, fq); S.done(cur); }
        if (!has_next) break;
#pragma unroll
        for (int a = 0; a < 2; ++a)
#pragma unroll
            for (int b = 0; b < 2; ++b)
#pragma unroll
                for (int m = 0; m < 4; ++m)
#pragma unroll
                    for (int n = 0; n < 2; ++n) acc[a][b][m][n] = (f32x4){0.f, 0.f, 0.f, 0.f};
        cur = nxt; cA = nA; cB = nB; ++ui;
        if constexpr (ALIGN_EPI) { if (wr == 1) PG8_BAR; }
    }
    PG8_WAIT_V(0);
    if constexpr (!ALIGN_EPI) { if (wr == 0) PG8_BAR; }
    PG8_BAR;
    if constexpr (Epi::AFTER_DRAIN) { E.fused(acc, cur, wr, wc, fr, fq, lds, wid, lane); S.done(cur); }
#undef PG8_SA
#undef PG8_SB
#undef PG8_STAGE
#undef PG8_LDA
#undef PG8_LDB
#undef PG8_MMA
#undef PG8_WAIT_V
#undef PG8_WAIT_L
#undef PG8_BAR
#undef PG8_SCHED
}
}

#define LAS __attribute__((address_space(3)))
typedef unsigned short bf16;
typedef unsigned v4u __attribute__((ext_vector_type(4)));
typedef unsigned v2u __attribute__((ext_vector_type(2)));
typedef float f32x4 __attribute__((ext_vector_type(4)));
typedef short bf16x8 __attribute__((ext_vector_type(8)));
constexpr int NWAVES = 8, NTHR = 512;
constexpr int D = 1024, NIN = 3072, FF = 4096, HW = 512;
constexpr int ROWS_REAL = pg8::ROWS_REAL, ROW_META = pg8::ROW_META, ROW_SAMP = pg8::ROW_SAMP, ROWS_USED = pg8::ROWS_USED, MROWS = pg8::MROWS;
constexpr int NB = 8, SEQ = 2048, NCH = 32, NSAMP = 128;
constexpr float EPS = 1e-6f;
constexpr int LDS_BYTES = 147456;

constexpr size_t KiB = 1024, MiB = 1u << 20;
constexpr size_t OFF_BAR = 768 * KiB, OFF_CNT = 784 * KiB, BAR_BYTES = 32 * KiB;
constexpr size_t OFF_SS2 = 0, OFF_SS3 = 128 * KiB, OFF_RS1 = 256 * KiB, OFF_LB = 384 * KiB, OFF_DSM = 512 * KiB;
constexpr size_t WS_WIN = 1 * MiB, WS_WOUT = 7 * MiB, WS_WUP = 9 * MiB, WS_WDN = 17 * MiB;
constexpr size_t WS_XB = 25 * MiB;
constexpr size_t WS_DS = 25 * MiB;
constexpr size_t WS_DEC = 89 * MiB;
constexpr size_t WS_LF = 89 * MiB + 512 * KiB;
constexpr size_t WS_SST = WS_LF;
constexpr size_t SZH = (size_t)MROWS * 512 * 2;
constexpr size_t WS_Q = 122 * MiB, WS_V = WS_Q + SZH, WS_GLU = WS_V + SZH, WS_G = WS_GLU + SZH, WS_QD = WS_G + SZH, WS_OI = WS_QD + SZH, WS_YM = WS_OI + SZH;
constexpr size_t WS_H1 = 25 * MiB;
constexpr size_t WS_HB = 90 * MiB;
constexpr size_t WS_HID = 122 * MiB + 512 * KiB;
constexpr size_t WS_ACC = 253 * MiB;
constexpr size_t WS_H1S = 253 * MiB + 512 * KiB;
constexpr size_t WS_HIDS = 254 * MiB + 128 * KiB;
constexpr size_t WS_END = 255 * MiB + 512 * KiB;
static_assert(WS_YM + 2 * SZH <= 252 * MiB + 1 && WS_HID + (size_t)MROWS * FF * 2 <= WS_END && WS_LF + (size_t)MROWS * 512 * 4 <= WS_Q, "ws map");

struct Args {
    const float *x_prompt, *x_sample, *state_hgrn, *state_conv, *meta, *hg_lb, *norm1_g, *w_in, *hg_onorm_g, *conv_w, *conv_b, *conv_ln_g, *conv_ln_b, *w_out, *norm2_g, *w_up, *w_down, *final_g;
    float* out; unsigned char* ws; int ph_lo, ph_hi, coop, pad;
};
constexpr size_t O_YP = 0, O_YS = (size_t)ROWS_REAL * D, O_SHP = O_YS + (size_t)NSAMP * D, O_SCP = O_SHP + (size_t)NB * 4 * 128 * 128, O_SHS = O_SCP + (size_t)NB * 30 * 512, O_SCS = O_SHS + (size_t)NSAMP * 4 * 128 * 128;

__device__ __forceinline__ unsigned f2bf(float f) { unsigned u = __builtin_bit_cast(unsigned, f); return (u + 0x7fffu + ((u >> 16) & 1u)) >> 16; }
typedef __bf16 hwbf16x2 __attribute__((ext_vector_type(2)));
typedef float hwf32x2 __attribute__((ext_vector_type(2)));
__device__ __forceinline__ unsigned pk2(float lo, float hi) { const hwf32x2 v = {lo, hi}; return __builtin_bit_cast(unsigned, __builtin_convertvector(v, hwbf16x2)); }
__device__ __forceinline__ float bf2f(unsigned short b) { return __builtin_bit_cast(float, (unsigned)b << 16); }
__device__ __forceinline__ float bflo(unsigned w) { return __builtin_bit_cast(float, w << 16); }
__device__ __forceinline__ float bfhi(unsigned w) { return __builtin_bit_cast(float, w & 0xffff0000u); }
__device__ __forceinline__ float wave_sum(float v) {
#pragma unroll
    for (int o = 1; o < 64; o <<= 1) v += __shfl_xor(v, o);
    return v;
}
#define LDS_WAIT() asm volatile("s_waitcnt lgkmcnt(0)" ::: "memory")

#define XB_TMO      128
#define XB_XCNT(j)  (256  + 64 * (j))
#define XB_XSUB(j)  (1280 + 64 * (j))
#define XB_XGEN(j)  (2304 + 64 * (j))
#define XB_TOP      3328
#define XB_TOPGEN   3392
#define XCD_BAR_WORDS 3456
#define XB_SPIN_CAP (1u << 18)

__device__ __forceinline__ unsigned xb_ld(unsigned* p)              { return __hip_atomic_load(p, __ATOMIC_RELAXED, __HIP_MEMORY_SCOPE_AGENT); }
__device__ __forceinline__ unsigned xb_add(unsigned* p, unsigned v) { return __hip_atomic_fetch_add(p, v, __ATOMIC_RELAXED, __HIP_MEMORY_SCOPE_AGENT); }
__device__ __forceinline__ unsigned xb_xcc_id() { return (unsigned)__builtin_amdgcn_s_getreg((3 << 11) | 20) & 0xFu; }
#define XB_SPIN(cond, bar) do { unsigned _sp = 0; while (cond) { __builtin_amdgcn_s_sleep(1); \
    if ((++_sp & 255u) == 0u) { if (xb_ld(&(bar)[XB_TMO])) break; if (_sp > XB_SPIN_CAP) { atomicAdd(&(bar)[XB_TMO], 1u); break; } } } } while (0)

struct XcdBarrier {
    unsigned* bar; unsigned x;
    volatile LAS unsigned* st;
};

__device__ __forceinline__ XcdBarrier xcd_barrier_post(unsigned* bar, volatile LAS unsigned* st) {
    XcdBarrier b; b.bar = bar; b.x = xb_xcc_id(); b.st = st;
    if (threadIdx.x == 0) (void)xb_add(&bar[XB_XCNT(b.x)], 1u);
    return b;
}
__device__ __forceinline__ void xcd_barrier_complete(unsigned* bar, unsigned x, unsigned& nloc, unsigned& nx) {
    const unsigned G = gridDim.x * gridDim.y * gridDim.z;
    unsigned sum, cnt, mine, sp = 0u;
    for (;;) {
        sum = 0u; cnt = 0u; mine = 0u;
#pragma unroll
        for (unsigned j = 0; j < 16; ++j) { const unsigned c = xb_ld(&bar[XB_XCNT(j)]); sum += c; cnt += (c > 0u) ? 1u : 0u; mine = (j == x) ? c : mine; }
        if (sum == G) break;
        __builtin_amdgcn_s_sleep(1);
        if ((++sp & 255u) == 0u) { if (xb_ld(&bar[XB_TMO])) break; if (sp > XB_SPIN_CAP) { atomicAdd(&bar[XB_TMO], 1u); break; } }
    }
    nloc = mine > 0u ? mine : 1u; nx = cnt > 0u ? cnt : 1u;
}

__device__ __forceinline__ void xcd_barrier(const XcdBarrier& b) {
    asm volatile("s_waitcnt vmcnt(0)" ::: "memory");
    __syncthreads();
    if (threadIdx.x == 0) {
        unsigned* bar = b.bar;
        __builtin_amdgcn_s_waitcnt(0);
        unsigned nloc = b.st[0], nx = b.st[1];
        if (nloc == 0u) { xcd_barrier_complete(bar, b.x, nloc, nx); b.st[0] = nloc; b.st[1] = nx; }
        const unsigned old = xb_add(&bar[XB_XSUB(b.x)], 1u);
        const unsigned gen = old / nloc;
        if (old + 1u == (gen + 1u) * nloc) {
            __builtin_amdgcn_fence(__ATOMIC_RELEASE, "agent");
            asm volatile("s_waitcnt vmcnt(0)" ::: "memory");
            const unsigned og = xb_add(&bar[XB_TOP], 1u);
            const unsigned tg = og / nx;
            if (og + 1u == (tg + 1u) * nx) xb_add(&bar[XB_TOPGEN], 1u);
            else XB_SPIN(xb_ld(&bar[XB_TOPGEN]) == tg, bar);
            __builtin_amdgcn_fence(__ATOMIC_ACQUIRE, "agent");
            xb_add(&bar[XB_XGEN(b.x)], 1u);
            asm volatile("s_waitcnt vmcnt(0)" ::: "memory");
        } else {
            XB_SPIN(xb_ld(&bar[XB_XGEN(b.x)]) == gen, bar);
            __builtin_amdgcn_fence(__ATOMIC_ACQUIRE, "agent");
            asm volatile("s_waitcnt vmcnt(0)" ::: "memory");
        }
    }
    __syncthreads();
}

template <bool IN_PERM>
__device__ __forceinline__ void p0_transpose_item(const float* W, const float* g, int K, int N, bf16* WT, LAS float* scr, int item, int lane) {
    const int nblk = N / 32, kb = item / nblk, nb = item % nblk, k0 = 64 * kb, n0 = 32 * nb;
    int s0 = n0;
    if (IN_PERM && n0 >= 2048) { const int j = (n0 - 2048) >> 8, w = (n0 - 2048) & 255; s0 = (w < 128) ? 2048 + 128 * j + w : 2560 + 128 * j + (w - 128); }
    float wv[32], gv[32];
#pragma unroll
    for (int i = 0; i < 32; ++i) { const int kk = 2 * i + (lane >> 5); wv[i] = __builtin_nontemporal_load(W + (size_t)(k0 + kk) * N + s0 + (lane & 31)); gv[i] = g ? g[k0 + kk] : 1.0f; }
#pragma unroll
    for (int i = 0; i < 32; ++i) { const int kk = 2 * i + (lane >> 5); scr[kk * 33 + (lane & 31)] = gv[i] * wv[i]; }
    LDS_WAIT(); asm volatile("" ::: "memory");
    const int c = lane & 7;
#pragma unroll
    for (int j = 0; j < 4; ++j) { const int n = (lane >> 3) + 8 * j; const LAS float* s = scr + (8 * c) * 33 + n;
        v4u o; o.x = pk2(s[0 * 33], s[1 * 33]); o.y = pk2(s[2 * 33], s[3 * 33]); o.z = pk2(s[4 * 33], s[5 * 33]); o.w = pk2(s[6 * 33], s[7 * 33]);
        *(v4u*)(WT + (size_t)(n0 + n) * K + k0 + 8 * c) = o; }
    LDS_WAIT(); asm volatile("" ::: "memory");
}
__device__ __forceinline__ void p0_prologue(const Args& a, LAS unsigned char* lds, int tid, int lane, int wave) {
    unsigned char* ws = a.ws;
    const int gw = blockIdx.x * NWAVES + wave, NGW = gridDim.x * NWAVES; const int gt = blockIdx.x * NTHR + tid, NGT = gridDim.x * NTHR;
    float* SS2 = (float*)(ws + OFF_SS2); float* SS3 = (float*)(ws + OFF_SS3); float* RS1 = (float*)(ws + OFF_RS1); float* LB = (float*)(ws + OFF_LB);
    for (int i = gt; i < MROWS; i += NGT) { SS2[i] = 0.f; SS3[i] = 0.f; }
    for (int i = gt; i < NSAMP * D / 4; i += NGT) ((f32x4*)(ws + WS_ACC))[i] = (f32x4){0.f, 0.f, 0.f, 0.f};
    if (gt < 512) { const float p0 = a.hg_lb[gt], p1 = a.hg_lb[512 + gt]; const float m = fmaxf(p0, p1), e0 = __expf(p0 - m), e1 = __expf(p1 - m); LB[gt] = e0 / (e0 + e1); }
    LAS float* scr = (LAS float*)(lds + wave * 16384);
    constexpr int I_IN = (D / 64) * (NIN / 32), I_OUT = (D / 64) * (D / 32), I_UP = (D / 64) * (FF / 32), I_DN = (FF / 64) * (D / 32);
    constexpr int NITEMS = I_IN + I_OUT + I_UP + I_DN;
    for (int it = gw; it < NITEMS; it += NGW) {
        int r = it;
        if (r < I_IN) { p0_transpose_item<true>(a.w_in, a.norm1_g, D, NIN, (bf16*)(ws + WS_WIN), scr, r, lane); continue; } r -= I_IN;
        if (r < I_OUT) { p0_transpose_item<false>(a.w_out, nullptr, D, D, (bf16*)(ws + WS_WOUT), scr, r, lane); continue; } r -= I_OUT;
        if (r < I_UP) { p0_transpose_item<false>(a.w_up, a.norm2_g, D, FF, (bf16*)(ws + WS_WUP), scr, r, lane); continue; } r -= I_UP;
        p0_transpose_item<false>(a.w_down, nullptr, FF, D, (bf16*)(ws + WS_WDN), scr, r, lane);
    }
    bf16* XB = (bf16*)(ws + WS_XB);
    {
        f32x4 v[4][4]; const float* xr[4]; int mb = gw;
#define P0_LOAD(mb_) do { _Pragma("unroll") for (int r = 0; r < 4; ++r) { const int m = (mb_) + r * NGW; xr[r] = m < MROWS ? pg8::resid_row(a.x_prompt, a.meta, a.x_sample, m) : nullptr; \
            _Pragma("unroll") for (int j = 0; j < 4; ++j) v[r][j] = xr[r] ? __builtin_nontemporal_load((const f32x4*)xr[r] + lane + 64 * j) : (f32x4){0.f, 0.f, 0.f, 0.f}; } } while (0)
        P0_LOAD(mb);
        while (mb < MROWS) {
            f32x4 c[4][4]; bool has[4]; const int cmb = mb;
#pragma unroll
            for (int r = 0; r < 4; ++r) { has[r] = xr[r] != nullptr;
#pragma unroll
                for (int j = 0; j < 4; ++j) c[r][j] = v[r][j]; }
            mb += NGW * 4; if (mb < MROWS) P0_LOAD(mb);
#pragma unroll
            for (int r = 0; r < 4; ++r) { const int m = cmb + r * NGW; if (m >= MROWS) break; float s = 0.f;
#pragma unroll
                for (int j = 0; j < 4; ++j) s += (c[r][j].x * c[r][j].x + c[r][j].y * c[r][j].y) + (c[r][j].z * c[r][j].z + c[r][j].w * c[r][j].w);
                s = wave_sum(s);
                if (lane == 0) RS1[m] = has[r] ? __builtin_amdgcn_rsqf(s * (1.0f / D) + EPS) : 0.f;
                unsigned long long* o8 = (unsigned long long*)(XB + (size_t)m * D) + lane;
#pragma unroll
                for (int j = 0; j < 4; ++j) o8[64 * j] = (unsigned long long)pk2(c[r][j].x, c[r][j].y) | ((unsigned long long)pk2(c[r][j].z, c[r][j].w) << 32); }
        }
#undef P0_LOAD
    }
}

template <int M0 = 0, int NT = 9>
__device__ __forceinline__ void skinny_slab(const bf16* A, int lda, const bf16* Bt, int ldb, int n0, int k_off, LAS unsigned char* lds, int wave, int lane, f32x4& r0, f32x4& r1, int arow0 = ROW_META) {
    const int fr = lane & 15, fq = lane >> 4; const int kb = k_off + wave * 128 + 8 * fq;
    const bf16* bp = Bt + (size_t)(n0 + fr) * ldb + kb; const bf16* ap = A + (size_t)(arow0 + 16 * M0 + fr) * lda + kb;
    bf16x8 fb[4], fa[4][NT];
#pragma unroll
    for (int ks = 0; ks < 4; ++ks) { fb[ks] = *(const bf16x8*)(bp + 32 * ks);
#pragma unroll
        for (int m = 0; m < NT; ++m) fa[ks][m] = *(const bf16x8*)(ap + (size_t)(16 * m) * lda + 32 * ks); }
    f32x4 acc[NT];
#pragma unroll
    for (int m = 0; m < NT; ++m) acc[m] = (f32x4){0.f, 0.f, 0.f, 0.f};
#pragma unroll
    for (int ks = 0; ks < 4; ++ks)
#pragma unroll
        for (int m = 0; m < NT; ++m) acc[m] = __builtin_amdgcn_mfma_f32_16x16x32_bf16(fb[ks], fa[ks][m], acc[m], 0, 0, 0);
    LAS f32x4* red = (LAS f32x4*)lds;
#pragma unroll
    for (int m = 0; m < NT; ++m) red[(wave * NT + m) * 64 + lane] = acc[m];
    __syncthreads();
    r0 = (f32x4){0.f, 0.f, 0.f, 0.f}; r1 = r0;
    if (wave < NT) {
#pragma unroll
        for (int w = 0; w < 8; ++w) r0 += red[(w * NT + wave) * 64 + lane]; }
    if (NT == 9 && wave == 0) {
#pragma unroll
        for (int w = 0; w < 8; ++w) r1 += red[(w * NT + 8) * 64 + lane]; }
    __syncthreads();
}
__device__ __forceinline__ v2u pack4(const f32x4 v) { return (v2u){pk2(v[0], v[1]), pk2(v[2], v[3])}; }
__device__ __forceinline__ void skinny_in(const Args& a, LAS unsigned char* lds, int u, int lane, int wave) {
    unsigned char* ws = a.ws; const bf16* XB = (const bf16*)(ws + WS_XB); const bf16* W = (const bf16*)(ws + WS_WIN); const float* RS1 = (const float*)(ws + OFF_RS1);
    const int fr = lane & 15, fq = lane >> 4;
    if (u < 128) {
        const int n0 = 16 * u, type = n0 >> 9, cw = (n0 & 511) + 4 * fq;
        f32x4 r[2]; skinny_slab(XB, D, W, D, n0, 0, lds, wave, lane, r[0], r[1]);
        f32x4 lb = {0.f, 0.f, 0.f, 0.f}; if (type == 1) lb = *(const f32x4*)((const float*)(ws + OFF_LB) + cw);
#pragma unroll
        for (int x = 0; x < 2; ++x) { if (x == 1 && wave != 0) break; const int row = ROW_META + 16 * (x ? 8 : wave) + fr; const float rs = RS1[row]; f32x4 v = r[x] * rs; const size_t off = (size_t)row * 512 + cw;
            if (type == 1) {
#pragma unroll
                for (int i = 0; i < 4; ++i) v[i] = __logf(lb[i] + (1.0f - lb[i]) * pg8::sigm(v[i]));
                *(f32x4*)((float*)(ws + WS_LF) + off) = v;
            } else {
                if (type != 2) {
#pragma unroll
                    for (int i = 0; i < 4; ++i) v[i] = pg8::silu_f(v[i]); }
                const int sel = (type == 0) ? 0 : (type == 2 ? 1 : 3);
                *(v2u*)((bf16*)(ws + WS_Q) + (size_t)sel * ((size_t)MROWS * 512) + off) = pack4(v); } }
    } else {
        const int p = (u - 128) >> 1, half = (u - 128) & 1, j = p >> 3, s = p & 7, n0 = 2048 + 256 * j + 16 * s;
        f32x4 ra, rb, dum;
        if (half == 0) { skinny_slab<0, 5>(XB, D, W, D, n0, 0, lds, wave, lane, ra, dum); skinny_slab<0, 5>(XB, D, W, D, n0 + 128, 0, lds, wave, lane, rb, dum); }
        else { skinny_slab<5, 4>(XB, D, W, D, n0, 0, lds, wave, lane, ra, dum); skinny_slab<5, 4>(XB, D, W, D, n0 + 128, 0, lds, wave, lane, rb, dum); }
        if (wave < (half ? 4 : 5)) { const int row = ROW_META + 16 * ((half ? 5 : 0) + wave) + fr; const float rs = RS1[row]; f32x4 g;
#pragma unroll
            for (int i = 0; i < 4; ++i) g[i] = ra[i] * rs * pg8::sigm(rb[i] * rs);
            *(v2u*)((bf16*)(ws + WS_GLU) + (size_t)row * 512 + 128 * j + 16 * s + 4 * fq) = pack4(g); }
    }
}
__device__ __forceinline__ void skinny_out(const Args& a, LAS unsigned char* lds, int u, int lane, int wave) {
    unsigned char* ws = a.ws; const int fr = lane & 15, fq = lane >> 4, n0 = 16 * (u & 63), grp = u >> 6;
    f32x4 r0, r1; const bf16* A = (const bf16*)(ws + WS_YM); const bf16* W = (const bf16*)(ws + WS_WOUT);
    if (grp == 0) skinny_slab<1, 2>(A, D, W, D, n0, 0, lds, wave, lane, r0, r1); else if (grp == 1) skinny_slab<3, 2>(A, D, W, D, n0, 0, lds, wave, lane, r0, r1);
    else if (grp == 2) skinny_slab<5, 2>(A, D, W, D, n0, 0, lds, wave, lane, r0, r1); else skinny_slab<7, 2>(A, D, W, D, n0, 0, lds, wave, lane, r0, r1);
    if (wave < 2) { const int row = ROW_META + 16 * (1 + 2 * grp + wave) + fr; const float* rp = pg8::resid_row(a.x_prompt, a.meta, a.x_sample, row);
        const f32x4 v = r0 + *(const f32x4*)(rp + n0 + 4 * fq); const size_t off = (size_t)row * D + n0 + 4 * fq;
        *(f32x4*)((float*)(ws + WS_H1S) + (size_t)(row - ROW_META) * D + n0 + 4 * fq) = v; *(v2u*)((bf16*)(ws + WS_HB) + off) = pack4(v);
        float ss = (v[0] * v[0] + v[1] * v[1]) + (v[2] * v[2] + v[3] * v[3]); ss += __shfl_xor(ss, 16); ss += __shfl_xor(ss, 32);
        if (fq == 0) atomicAdd((float*)(ws + OFF_SS2) + row, ss); }
}
__device__ __forceinline__ void skinny_up(const Args& a, LAS unsigned char* lds, int u, int lane, int wave) {
    unsigned char* ws = a.ws; const int fr = lane & 15, fq = lane >> 4, n0 = 16 * u;
    f32x4 r0, r1; skinny_slab<1, 8>((const bf16*)(ws + WS_HB), D, (const bf16*)(ws + WS_WUP), D, n0, 0, lds, wave, lane, r0, r1);
    const int row = ROW_SAMP + 16 * wave + fr; const float rs = __builtin_amdgcn_rsqf(((const float*)(ws + OFF_SS2))[row] * (1.0f / D) + EPS);
    f32x4 v = r0 * rs;
#pragma unroll
    for (int i = 0; i < 4; ++i) { const float t = fmaxf(v[i], 0.f); v[i] = t * t; }
    *(v2u*)((bf16*)(ws + WS_HIDS) + (size_t)(row - ROW_META) * FF + n0 + 4 * fq) = pack4(v);
}
__device__ __forceinline__ void skinny_down(const Args& a, LAS unsigned char* lds, int u, int lane, int wave) {
    unsigned char* ws = a.ws; const int fr = lane & 15, fq = lane >> 4, n0 = 16 * (u & 63), kc = u >> 6;
    f32x4 r0, r1; skinny_slab<1, 8>((const bf16*)(ws + WS_HIDS), FF, (const bf16*)(ws + WS_WDN), FF, n0, kc * 1024, lds, wave, lane, r0, r1, 0);
    float* p = (float*)(ws + WS_ACC) + (size_t)(16 * wave + fr) * D + n0 + 4 * fq;
#pragma unroll
    for (int i = 0; i < 4; ++i) atomicAdd(p + i, r0[i]);
}

constexpr int L_QD = 0, L_KI = 17408, L_KIT = 34816, L_VT = 55296, L_SC = 75776, L_PART = 84992, L_DEC = 93184;
__device__ __forceinline__ int tsw(int row, int chunk) { return row * 160 + 16 * (chunk ^ ((row >> 3) & 7)); }
__device__ __forceinline__ bf16x8 lds_frag(LAS unsigned char* base, int row, int stride_b, int kbyte) { return *(const LAS bf16x8*)(base + row * stride_b + kbyte); }
#define BAR_LDS() do { asm volatile("s_waitcnt lgkmcnt(0)" ::: "memory"); __builtin_amdgcn_s_barrier(); asm volatile("" ::: "memory"); } while (0)
struct ChunkIn { f32x4 lf[4]; v2u q[4], v[4]; };
__device__ __forceinline__ void chunk_load(const Args& a, int item, int tid, ChunkIn& in) {
    unsigned char* ws = a.ws; const bool meta = item >= 1024; const int h = meta ? item - 1024 : (item & 3), bn = meta ? 0 : (item >> 2);
    const float* LF = (const float*)(ws + WS_LF); const bf16* Q = (const bf16*)(ws + WS_Q); const bf16* V = (const bf16*)(ws + WS_V);
    const int c4 = tid & 31, ts = tid >> 5; const bool valid = !meta || ts >= 12;
    const size_t cbase = (size_t)(meta ? ROW_META + 4 * (ts - 12) : bn * 64 + 4 * ts) * 512 + h * 128 + 4 * c4;
#pragma unroll
    for (int i = 0; i < 4; ++i) { in.lf[i] = (f32x4){0.f, 0.f, 0.f, 0.f}; in.q[i] = (v2u){0u, 0u}; in.v[i] = (v2u){0u, 0u}; }
    if (valid) {
#pragma unroll
        for (int i = 0; i < 4; ++i) { in.lf[i] = __builtin_nontemporal_load((const f32x4*)(LF + cbase + (size_t)i * 512)); in.q[i] = __builtin_nontemporal_load((const v2u*)(Q + cbase + (size_t)i * 512)); in.v[i] = __builtin_nontemporal_load((const v2u*)(V + cbase + (size_t)i * 512)); } }
}
__device__ __forceinline__ void hgrn_chunk_item(const Args& a, LAS unsigned char* lds, int item, const ChunkIn& in, int tid, int lane, int wave) {
    unsigned char* ws = a.ws;
    const bool meta = item >= 1024; const int h = meta ? item - 1024 : (item & 3), bn = meta ? 0 : (item >> 2);
    bf16* QDg = (bf16*)(ws + WS_QD); bf16* OI = (bf16*)(ws + WS_OI); float* DEC = (float*)(ws + WS_DEC);
    bf16* DSo = meta ? (bf16*)(ws + OFF_DSM) + (size_t)h * 16384 : (bf16*)(ws + WS_DS) + ((size_t)bn * 4 + h) * 16384;
    const int c4 = tid & 31, ts = tid >> 5;
    const size_t cbase = (size_t)(bn * 64 + 4 * ts) * 512 + h * 128 + 4 * c4;
    LAS float* PART = (LAS float*)(lds + L_PART); LAS float* DECl = (LAS float*)(lds + L_DEC);
    f32x4 c[4];
    c[0] = in.lf[0]; c[1] = c[0] + in.lf[1]; c[2] = c[1] + in.lf[2]; c[3] = c[2] + in.lf[3];
    *(LAS f32x4*)(PART + ts * 128 + 4 * c4) = c[3];
    BAR_LDS();
    f32x4 off = {0.f, 0.f, 0.f, 0.f}, bend = off;
#pragma unroll
    for (int j = 0; j < 16; ++j) { const f32x4 pj = *(const LAS f32x4*)(PART + j * 128 + 4 * c4); bend += pj; if (j < ts) off += pj; }
    unsigned kiw[4][4];
#pragma unroll
    for (int i = 0; i < 4; ++i) {
        const f32x4 bcur = off + c[i]; f32x4 qd, ki;
        const f32x4 qf = {bflo(in.q[i].x), bfhi(in.q[i].x), bflo(in.q[i].y), bfhi(in.q[i].y)};
#pragma unroll
        for (int j = 0; j < 4; ++j) { const float e = __expf(bcur[j]); qd[j] = qf[j] * e; ki[j] = (1.0f - __expf(in.lf[i][j])) * __builtin_amdgcn_rcpf(e); }
        const int t = 4 * ts + i;
        const v2u qdp = {pk2(qd[0], qd[1]), pk2(qd[2], qd[3])}, kip = {pk2(ki[0], ki[1]), pk2(ki[2], ki[3])};
        *(LAS v2u*)(lds + L_QD + t * 272 + 8 * c4) = qdp; *(LAS v2u*)(lds + L_KI + t * 272 + 8 * c4) = kip;
        if (!meta) *(v2u*)(QDg + cbase + (size_t)i * 512) = qdp;
        kiw[0][i] = kip.x & 0xffffu; kiw[1][i] = kip.x >> 16; kiw[2][i] = kip.y & 0xffffu; kiw[3][i] = kip.y >> 16;
    }
#pragma unroll
    for (int j = 0; j < 4; ++j) {
        *(LAS v2u*)(lds + L_KIT + tsw(4 * c4 + j, ts >> 1) + 8 * (ts & 1)) = (v2u){kiw[j][0] | (kiw[j][1] << 16), kiw[j][2] | (kiw[j][3] << 16)};
        unsigned vb[4];
#pragma unroll
        for (int i = 0; i < 4; ++i) { const unsigned w = (j < 2) ? in.v[i].x : in.v[i].y; vb[i] = (j & 1) ? (w >> 16) : (w & 0xffffu); }
        *(LAS v2u*)(lds + L_VT + tsw(4 * c4 + j, ts >> 1) + 8 * (ts & 1)) = (v2u){vb[0] | (vb[1] << 16), vb[2] | (vb[3] << 16)};
    }
    if (ts == 0) { f32x4 dc;
#pragma unroll
        for (int j = 0; j < 4; ++j) dc[j] = __expf(bend[j]);
        *(LAS f32x4*)(DECl + 4 * c4) = dc; if (!meta) *(f32x4*)(DEC + (size_t)bn * 512 + h * 128 + 4 * c4) = dc; }
    BAR_LDS();
    const int fr = lane & 15, fq = lane >> 4;
    if (!meta) {
#pragma unroll
        for (int x = 0; x < 2; ++x) { const int idx = wave * 2 + x, tt = idx >> 2, st = idx & 3;
            f32x4 acc = {0.f, 0.f, 0.f, 0.f};
            if (st <= tt) {
#pragma unroll
                for (int ks = 0; ks < 4; ++ks) { const bf16x8 fa = lds_frag(lds + L_KI, 16 * st + fr, 272, 64 * ks + 16 * fq), fb = lds_frag(lds + L_QD, 16 * tt + fr, 272, 64 * ks + 16 * fq);
                    acc = __builtin_amdgcn_mfma_f32_16x16x32_bf16(fa, fb, acc, 0, 0, 0); }
                const int t = 16 * tt + fr, s0 = 16 * st + 4 * fq;
#pragma unroll
                for (int r = 0; r < 4; ++r) if (s0 + r > t) acc[r] = 0.f;
            }
            *(LAS v2u*)(lds + L_SC + (16 * tt + fr) * 144 + (16 * st + 4 * fq) * 2) = (v2u){pk2(acc[0], acc[1]), pk2(acc[2], acc[3])}; }
    }
    BAR_LDS();
    const int vt_i = wave;
    const bf16x8 fv0 = *(const LAS bf16x8*)(lds + L_VT + tsw(16 * vt_i + fr, fq)), fv1 = *(const LAS bf16x8*)(lds + L_VT + tsw(16 * vt_i + fr, 4 + fq));
    if (!meta) {
#pragma unroll
        for (int tt = 0; tt < 4; ++tt) { f32x4 acc = {0.f, 0.f, 0.f, 0.f};
            const bf16x8 s0 = lds_frag(lds + L_SC, 16 * tt + fr, 144, 16 * fq), s1 = lds_frag(lds + L_SC, 16 * tt + fr, 144, 64 + 16 * fq);
            acc = __builtin_amdgcn_mfma_f32_16x16x32_bf16(fv0, s0, acc, 0, 0, 0); acc = __builtin_amdgcn_mfma_f32_16x16x32_bf16(fv1, s1, acc, 0, 0, 0);
            *(v2u*)(OI + (size_t)(bn * 64 + 16 * tt + fr) * 512 + h * 128 + 16 * vt_i + 4 * fq) = (v2u){pk2(acc[0], acc[1]), pk2(acc[2], acc[3])}; }
    }
#pragma unroll
    for (int dt = 0; dt < 8; ++dt) { f32x4 acc = {0.f, 0.f, 0.f, 0.f};
        const bf16x8 k0 = *(const LAS bf16x8*)(lds + L_KIT + tsw(16 * dt + fr, fq)), k1 = *(const LAS bf16x8*)(lds + L_KIT + tsw(16 * dt + fr, 4 + fq));
        acc = __builtin_amdgcn_mfma_f32_16x16x32_bf16(k0, fv0, acc, 0, 0, 0); acc = __builtin_amdgcn_mfma_f32_16x16x32_bf16(k1, fv1, acc, 0, 0, 0);
        const f32x4 dc = *(const LAS f32x4*)(DECl + 16 * dt + 4 * fq);
        const f32x4 sc = acc * dc; *(v2u*)(DSo + (size_t)(16 * vt_i + fr) * 128 + 16 * dt + 4 * fq) = (v2u){pk2(sc[0], sc[1]), pk2(sc[2], sc[3])}; }
    BAR_LDS();
}

__device__ __forceinline__ void conv_item(const Args& a, LAS unsigned char* lds, int item, int tid, int lane, int wave) {
    unsigned char* ws = a.ws; const bf16* GLU = (const bf16*)(ws + WS_GLU); bf16* YM = (bf16*)(ws + WS_YM);
    const int b = item >> 5, g = item & 31, c = tid; const int r0 = b * SEQ + g * 64;
    float w[31];
#pragma unroll
    for (int j = 0; j < 31; ++j) w[j] = a.conv_w[j * 512 + c];
    const float bias = a.conv_b[c];
    LAS float* DW = (LAS float*)lds;
    LAS unsigned short* GW = (LAS unsigned short*)(lds + 65536);
    float lg[8], lb[8];
#pragma unroll
    for (int i = 0; i < 8; ++i) { lg[i] = a.conv_ln_g[8 * lane + i]; lb[i] = a.conv_ln_b[8 * lane + i]; }
    v4u stg[8];
#define CONV_LOAD(grp_) do { _Pragma("unroll") for (int k = 0; k < 8; ++k) { const int q = tid + 512 * k; const int rr = q >> 6, cc = (q & 63) * 8; stg[k] = (v4u){0u, 0u, 0u, 0u}; \
            if (rr < 62) { const int tp = g * 64 + 32 * (grp_) + rr - 30; \
                if (tp >= 0) stg[k] = *(const v4u*)(GLU + (size_t)(b * SEQ + tp) * 512 + cc); else if (tp >= -16) stg[k] = *(const v4u*)(GLU + (size_t)(ROW_META + 16 + tp) * 512 + cc); } } } while (0)
    CONV_LOAD(0);
    for (int grp = 0; grp < 2; ++grp) {
        const int rg = r0 + 32 * grp;
#pragma unroll
        for (int k = 0; k < 8; ++k) { const int q = tid + 512 * k; const int rr = q >> 6, cc = (q & 63) * 8; if (rr < 62) *(LAS v4u*)(GW + rr * 512 + cc) = stg[k]; }
        if (grp == 0) CONV_LOAD(1);
        BAR_LDS();
        if (g == 31 && grp == 1) {
#pragma unroll 1
            for (int i = 2; i < 32; ++i) a.out[O_SCP + (size_t)(b * 30 + i - 2) * 512 + c] = bf2f(GW[(30 + i) * 512 + c]); }
#pragma unroll 1
        for (int ib = 0; ib < 4; ++ib) {
            const LAS unsigned short* gp = GW + ib * 8 * 512 + c; LAS float* dp = DW + ib * 8 * 512 + c;
            float xv[38];
#pragma unroll
            for (int i = 0; i < 38; ++i) xv[i] = bf2f(gp[i * 512]);
#pragma unroll
            for (int i = 0; i < 8; ++i) {
                float acc = bias;
#pragma unroll
                for (int j = 0; j < 31; ++j) acc += w[j] * xv[i + j];
                dp[i * 512] = acc;
            }
        }
        __syncthreads();
#pragma unroll
        for (int rr = 0; rr < 4; ++rr) { const int i = wave + 8 * rr;
            const f32x4 x0 = *(const LAS f32x4*)(DW + i * 512 + 8 * lane), x1 = *(const LAS f32x4*)(DW + i * 512 + 8 * lane + 4);
            const float mean = wave_sum((x0[0] + x0[1]) + (x0[2] + x0[3]) + (x1[0] + x1[1]) + (x1[2] + x1[3])) * (1.0f / 512.0f);
            const f32x4 d0 = x0 - mean, d1 = x1 - mean;
            const float var = wave_sum((d0[0] * d0[0] + d0[1] * d0[1]) + (d0[2] * d0[2] + d0[3] * d0[3]) + (d1[0] * d1[0] + d1[1] * d1[1]) + (d1[2] * d1[2] + d1[3] * d1[3])) * (1.0f / 512.0f);
            const float rstd = __builtin_amdgcn_rsqf(var + EPS);
            float y[8];
#pragma unroll
            for (int k = 0; k < 4; ++k) { y[k] = pg8::silu_f(d0[k] * rstd * lg[k] + lb[k]); y[4 + k] = pg8::silu_f(d1[k] * rstd * lg[4 + k] + lb[4 + k]); }
            *(v4u*)(YM + (size_t)(rg + i) * 1024 + 512 + 8 * lane) = (v4u){pk2(y[0], y[1]), pk2(y[2], y[3]), pk2(y[4], y[5]), pk2(y[6], y[7])}; }
        __syncthreads();
    }
}

struct SConvIn { float xs[30], wv[31], glu, lg, lb, bias; };
__device__ __forceinline__ void sample_conv_load(const Args& a, int s, int tid, SConvIn& in) {
    const int c = tid; const float* sc = a.state_conv + (size_t)s * 30 * 512 + c;
#pragma unroll
    for (int j = 0; j < 30; ++j) { in.xs[j] = __builtin_nontemporal_load(sc + j * 512); in.wv[j] = a.conv_w[j * 512 + c]; }
    in.wv[30] = a.conv_w[30 * 512 + c];
    in.glu = bf2f(((const bf16*)(a.ws + WS_GLU))[(size_t)(ROW_SAMP + s) * 512 + c]);
    in.lg = a.conv_ln_g[c]; in.lb = a.conv_ln_b[c]; in.bias = a.conv_b[c];
}
__device__ __forceinline__ void sample_conv_item(const Args& a, LAS unsigned char* lds, int s, const SConvIn& in, int tid, int lane, int wave) {
    unsigned char* ws = a.ws; const int row = ROW_SAMP + s; bf16* YM = (bf16*)(ws + WS_YM);
    LAS float* RED = (LAS float*)(lds + 96 * 1024);
    const int c = tid; float* so = a.out + O_SCS + (size_t)s * 30 * 512 + c;
    float acc = in.bias;
#pragma unroll
    for (int j = 0; j < 30; ++j) acc += in.wv[j] * in.xs[j];
    acc += in.wv[30] * in.glu;
#pragma unroll
    for (int j = 1; j < 30; ++j) so[(j - 1) * 512] = in.xs[j];
    so[29 * 512] = in.glu;
    float sm = wave_sum(acc); if (lane == 0) RED[wave] = sm;
    BAR_LDS();
    float mean = 0.f;
#pragma unroll
    for (int j = 0; j < 8; ++j) mean += RED[j];
    mean *= (1.0f / 512.0f);
    const float dd = acc - mean; float sv = wave_sum(dd * dd); if (lane == 0) RED[8 + wave] = sv;
    BAR_LDS();
    float var = 0.f;
#pragma unroll
    for (int j = 0; j < 8; ++j) var += RED[8 + j];
    const float rstd = __builtin_amdgcn_rsqf(var * (1.0f / 512.0f) + EPS);
    YM[(size_t)row * 1024 + 512 + c] = (unsigned short)f2bf(pg8::silu_f(dd * rstd * in.lg + in.lb));
    BAR_LDS();
}
struct SampIn { f32x4 S[8]; f32x4 lf0, lf1; v4u q; v2u v; };
__device__ __forceinline__ void samp_load(const Args& a, int it, int tid, SampIn& in) {
    unsigned char* ws = a.ws; const int s = it >> 2, h = it & 3, vq = tid & 31, dg = tid >> 5; const size_t hb = (size_t)(ROW_SAMP + s) * 512 + h * 128;
    const float* Sin = a.state_hgrn + ((size_t)it * 128 + 8 * dg) * 128 + 4 * vq;
#pragma unroll
    for (int dd = 0; dd < 8; ++dd) in.S[dd] = __builtin_nontemporal_load((const f32x4*)(Sin + (size_t)dd * 128));
    const float* LF = (const float*)(ws + WS_LF) + hb + 8 * dg; in.lf0 = *(const f32x4*)LF; in.lf1 = *(const f32x4*)(LF + 4);
    in.q = *(const v4u*)((const bf16*)(ws + WS_Q) + hb + 8 * dg); in.v = *(const v2u*)((const bf16*)(ws + WS_V) + hb + 4 * vq);
}
__device__ __forceinline__ void samp_item(const Args& a, LAS unsigned char* lds, int it, const SampIn& in, int tid, int lane, int wave) {
    unsigned char* ws = a.ws; const int s = it >> 2, h = it & 3, vq = tid & 31, dg = tid >> 5; const int row = ROW_SAMP + s; const size_t hb = (size_t)row * 512 + h * 128;
    LAS float* OP = (LAS float*)(lds + 100 * 1024);
    float ga = 0.f, gb = 0.f, na = 0.f, nb = 0.f;
    if (wave == 0) { const bf16* G = (const bf16*)(ws + WS_G); ga = bf2f(G[hb + lane]); gb = bf2f(G[hb + 64 + lane]); na = a.hg_onorm_g[lane]; nb = a.hg_onorm_g[64 + lane]; }
    const f32x4 v4 = {bflo(in.v.x), bfhi(in.v.x), bflo(in.v.y), bfhi(in.v.y)};
    float* Sout = a.out + O_SHS + ((size_t)it * 128 + 8 * dg) * 128 + 4 * vq;
    f32x4 o4 = {0.f, 0.f, 0.f, 0.f};
#pragma unroll
    for (int dd = 0; dd < 8; ++dd) { const float lf = dd < 4 ? in.lf0[dd & 3] : in.lf1[dd & 3]; const unsigned qw = in.q[dd >> 1]; const float q = (dd & 1) ? bfhi(qw) : bflo(qw);
        const float f = __expf(lf), k = 1.0f - f; const f32x4 S = in.S[dd] * f + v4 * k; *(f32x4*)(Sout + (size_t)dd * 128) = S; o4 += S * q; }
    *(LAS f32x4*)(OP + dg * 128 + 4 * vq) = o4;
    BAR_LDS();
    if (wave == 0) { float oa = 0.f, ob = 0.f;
#pragma unroll
        for (int j = 0; j < 16; ++j) { oa += OP[j * 128 + lane]; ob += OP[j * 128 + 64 + lane]; }
        const float rstd = __builtin_amdgcn_rsqf(wave_sum(oa * oa + ob * ob) * (1.0f / 128.0f) + EPS);
        bf16* YM = (bf16*)(ws + WS_YM);
        YM[(size_t)row * 1024 + h * 128 + lane] = (unsigned short)f2bf(oa * rstd * na * ga); YM[(size_t)row * 1024 + h * 128 + 64 + lane] = (unsigned short)f2bf(ob * rstd * nb * gb); }
    BAR_LDS();
}

__device__ __forceinline__ void scan_phase(const Args& a, int tid) {
    unsigned char* ws = a.ws; const bf16* DS = (const bf16*)(ws + WS_DS); const bf16* DSM = (const bf16*)(ws + OFF_DSM); const float* DEC = (const float*)(ws + WS_DEC); bf16* SST = (bf16*)(ws + WS_SST);
    for (int e = blockIdx.x * NTHR + tid; e < NB * 4 * 128 * 32; e += gridDim.x * NTHR) {
        const int d4 = (e & 31) * 4, v = (e >> 5) & 127, h = (e >> 12) & 3, b = e >> 14;
        const v2u m0 = *(const v2u*)(DSM + (size_t)h * 16384 + v * 128 + d4);
        f32x4 S = {bflo(m0.x), bfhi(m0.x), bflo(m0.y), bfhi(m0.y)};
        const bf16* dsp = DS + ((size_t)(b * 32) * 4 + h) * 16384 + v * 128 + d4; bf16* ssp = SST + ((size_t)(b * 32) * 4 + h) * 16384 + v * 128 + d4; const float* dcp = DEC + (size_t)(b * 32) * 512 + h * 128 + d4;
        {
            v2u ds[8]; f32x4 dc[8];
#define SCAN_LOAD(n0_) do { _Pragma("unroll") for (int i = 0; i < 8; ++i) { ds[i] = __builtin_nontemporal_load((const v2u*)(dsp + (size_t)((n0_) + i) * 65536)); dc[i] = *(const f32x4*)(dcp + (size_t)((n0_) + i) * 512); } } while (0)
            SCAN_LOAD(0);
#pragma unroll 1
            for (int n0 = 0; n0 < NCH; n0 += 8) {
                v2u cds[8]; f32x4 cdc[8];
#pragma unroll
                for (int i = 0; i < 8; ++i) { cds[i] = ds[i]; cdc[i] = dc[i]; }
                if (n0 + 8 < NCH) SCAN_LOAD(n0 + 8);
#pragma unroll
                for (int i = 0; i < 8; ++i) { *(v2u*)(ssp + (size_t)(n0 + i) * 65536) = (v2u){pk2(S[0], S[1]), pk2(S[2], S[3])};
                    const f32x4 dv = {bflo(cds[i].x), bfhi(cds[i].x), bflo(cds[i].y), bfhi(cds[i].y)}; S = S * cdc[i] + dv; }
            }
#undef SCAN_LOAD
        }
        float* so = a.out + O_SHP + ((size_t)(b * 4 + h) * 128 + d4) * 128 + v;
        so[0] = S[0]; so[128] = S[1]; so[256] = S[2]; so[384] = S[3];
    }
}

__device__ __forceinline__ void ointer_item(const Args& a, int item, int lane, int wave) {
    unsigned char* ws = a.ws; const bf16* QD = (const bf16*)(ws + WS_QD); const bf16* SST = (const bf16*)(ws + WS_SST); const bf16* OI = (const bf16*)(ws + WS_OI); const bf16* G = (const bf16*)(ws + WS_G); bf16* YM = (bf16*)(ws + WS_YM);
    const int bn = item >> 1, h = (item & 1) * 2 + (wave >> 2), tt = wave & 3, fr = lane & 15, fq = lane >> 4;
    const int row = bn * 64 + 16 * tt + fr; const size_t hb = (size_t)row * 512 + h * 128;
    bf16x8 fb[4];
#pragma unroll
    for (int ks = 0; ks < 4; ++ks) fb[ks] = __builtin_nontemporal_load((const bf16x8*)(QD + hb + 32 * ks + 8 * fq));
    const bf16* Sb = SST + ((size_t)bn * 4 + h) * 16384;
    bf16x8 fa[8][4]; v2u oi[8], gg[8]; f32x4 ogv[8];
#pragma unroll
    for (int vt = 0; vt < 8; ++vt) ogv[vt] = *(const f32x4*)(a.hg_onorm_g + 16 * vt + 4 * fq);
#pragma unroll
    for (int vt = 0; vt < 8; ++vt) {
#pragma unroll
        for (int ks = 0; ks < 4; ++ks) fa[vt][ks] = *(const bf16x8*)(Sb + (size_t)(16 * vt + fr) * 128 + 32 * ks + 8 * fq);
        oi[vt] = __builtin_nontemporal_load((const v2u*)(OI + hb + 16 * vt + 4 * fq)); gg[vt] = __builtin_nontemporal_load((const v2u*)(G + hb + 16 * vt + 4 * fq)); }
    __builtin_amdgcn_sched_barrier(0);
    f32x4 o[8]; float ss = 0.f;
#pragma unroll
    for (int vt = 0; vt < 8; ++vt) { f32x4 acc = {bflo(oi[vt].x), bfhi(oi[vt].x), bflo(oi[vt].y), bfhi(oi[vt].y)};
#pragma unroll
        for (int ks = 0; ks < 4; ++ks) acc = __builtin_amdgcn_mfma_f32_16x16x32_bf16(fa[vt][ks], fb[ks], acc, 0, 0, 0);
        ss += (acc[0] * acc[0] + acc[1] * acc[1]) + (acc[2] * acc[2] + acc[3] * acc[3]); o[vt] = acc; }
    ss += __shfl_xor(ss, 16); ss += __shfl_xor(ss, 32);
    const float rstd = __builtin_amdgcn_rsqf(ss * (1.0f / 128.0f) + EPS);
#pragma unroll
    for (int vt = 0; vt < 8; ++vt) { const f32x4 og = ogv[vt];
        const float y0 = o[vt][0] * rstd * og[0] * bflo(gg[vt].x), y1 = o[vt][1] * rstd * og[1] * bfhi(gg[vt].x), y2 = o[vt][2] * rstd * og[2] * bflo(gg[vt].y), y3 = o[vt][3] * rstd * og[3] * bfhi(gg[vt].y);
        *(v2u*)(YM + (size_t)row * 1024 + h * 128 + 16 * vt + 4 * fq) = (v2u){pk2(y0, y1), pk2(y2, y3)}; }
}

__device__ __forceinline__ void final_norm(const Args& a, int lane, int wave, int m_first) {
    const float* SS3 = (const float*)(a.ws + OFF_SS3);
    f32x4 g[4];
#pragma unroll
    for (int j = 0; j < 4; ++j) g[j] = ((const f32x4*)a.final_g)[lane + 64 * j];
    for (int m = m_first + blockIdx.x * NWAVES + wave; m < ROWS_REAL + NSAMP; m += gridDim.x * NWAVES) {
        f32x4* p = (f32x4*)(a.out + (size_t)m * D) + lane;
        if (m < ROWS_REAL) {
            const float rs = __builtin_amdgcn_rsqf(SS3[m] * (1.0f / D) + EPS);
#pragma unroll
            for (int j = 0; j < 4; ++j) p[64 * j] = p[64 * j] * rs * g[j];
        } else {
            const f32x4* h1 = (const f32x4*)((const float*)(a.ws + WS_H1S) + (size_t)(ROW_SAMP - ROW_META + m - ROWS_REAL) * D) + lane; const f32x4* ac = (const f32x4*)((const float*)(a.ws + WS_ACC) + (size_t)(m - ROWS_REAL) * D) + lane;
            f32x4 v[4]; float s = 0.f;
#pragma unroll
            for (int j = 0; j < 4; ++j) { v[j] = h1[64 * j] + ac[64 * j]; s += (v[j].x * v[j].x + v[j].y * v[j].y) + (v[j].z * v[j].z + v[j].w * v[j].w); }
            const float rs = __builtin_amdgcn_rsqf(wave_sum(s) * (1.0f / D) + EPS);
#pragma unroll
            for (int j = 0; j < 4; ++j) p[64 * j] = v[j] * rs * g[j];
        }
    }
}

__global__ void __launch_bounds__(NTHR, 2) hymba_fwd(Args args) {
    extern __shared__ __attribute__((aligned(16))) unsigned char lds_raw[];
    LAS unsigned char* lds = (LAS unsigned char*)lds_raw;
    const int tid = threadIdx.x, lane = tid & 63, wave = __builtin_amdgcn_readfirstlane(tid >> 6);
    const int G = gridDim.x, bx = blockIdx.x;
    unsigned char* ws = args.ws;
    const int lo = args.ph_lo, hi = args.ph_hi;
#ifndef PHMASK
#define PHMASK 0x1ff
#endif
#define IN(k) (((PHMASK >> (k)) & 1) && lo <= (k) && (k) < hi)
#ifndef PROBE_BLK
#define PROBE_BLK 0
#endif
#ifndef PROBE_A
#define PROBE_A 0
#define PROBE_B 0
#endif
    unsigned long long ts_a = 0, ts_b = 0;
#define STAMP(i) do { if (PROBE_B > PROBE_A) { if ((i) == PROBE_A) ts_a = __builtin_amdgcn_s_memrealtime(); if ((i) == PROBE_B) ts_b = __builtin_amdgcn_s_memrealtime(); } } while (0)
    STAMP(0);
    volatile LAS unsigned* bar_st = (volatile LAS unsigned*)(lds + LDS_BYTES - 64);
    if (tid < 2) bar_st[tid] = 0u;
    __syncthreads();
    XcdBarrier xbar; xbar.bar = (unsigned*)(ws + OFF_BAR); xbar.x = 0; xbar.st = bar_st;
    if (args.coop) xbar = xcd_barrier_post((unsigned*)(ws + OFF_BAR), bar_st);
    if (args.coop == 2) cg::this_grid().sync();
#define SEAM(k) do { if (IN(k) && IN((k) + 1)) { xcd_barrier(xbar); } STAMP((k) + 1); } while (0)
    if (IN(0)) { p0_prologue(args, lds, tid, lane, wave); }
    SEAM(0);
    if (IN(1)) {
        pg8::Gemm g{(const pg8::bf16_t*)(ws + WS_XB), (const pg8::bf16_t*)(ws + WS_WIN), MROWS, NIN, D}; pg8::StaticOrder S; S.init(ROWS_REAL, NIN, G, bx);
        pg8::EpiIn E{(bf16*)(ws + WS_Q), (bf16*)(ws + WS_V), (bf16*)(ws + WS_G), (bf16*)(ws + WS_GLU), (float*)(ws + WS_LF), (const float*)(ws + OFF_RS1), (const float*)(ws + OFF_LB)};
        pg8::gemm_phase<pg8::EpiIn, pg8::StaticOrder, true, true>(lds, g, S, E);
        for (int u = bx; u < 192; u += G) skinny_in(args, lds, u, lane, wave);
    }
    SEAM(1);
    if (IN(2)) {
#ifndef P2SEL
#define P2SEL 7
#endif
        if ((P2SEL & 2) && bx < 256) conv_item(args, lds, bx, tid, lane, wave);
        STAMP(10);
        if (P2SEL & 1) { ChunkIn cin; int it = bx; if (it < 1028) chunk_load(args, it, tid, cin);
            while (it < 1028) { ChunkIn cur = cin; const int nx = it + G; if (nx < 1028) chunk_load(args, nx, tid, cin); hgrn_chunk_item(args, lds, it, cur, tid, lane, wave); it = nx; } }
        STAMP(11);
        if (P2SEL & 4) { const bool has_sc = bx >= 128 && bx - 128 < NSAMP; SConvIn sci;
            if (has_sc) sample_conv_load(args, bx - 128, tid, sci);
            const bool reb = (G == 256); const int n_s = reb ? (bx < 4 ? 1 : (bx < 8 ? 3 : 2)) : (1 << 30);
            SampIn sin; int it = bx, k = 0; if (it < 4 * NSAMP) samp_load(args, it, tid, sin);
            while (it < 4 * NSAMP && k < n_s) { SampIn cur = sin; const int nx = (reb && k == 1) ? bx + 252 : it + G; if (k + 1 < n_s && nx < 4 * NSAMP) samp_load(args, nx, tid, sin); samp_item(args, lds, it, cur, tid, lane, wave); it = nx; ++k; }
            if (has_sc) sample_conv_item(args, lds, bx - 128, sci, tid, lane, wave); }
        STAMP(12);
    }
    SEAM(2);
    if (IN(3)) { scan_phase(args, tid); }
    SEAM(3);
    if (IN(4)) {
        for (int it0 = bx; it0 < NB * NCH * 2; it0 += 2 * G) { ointer_item(args, it0, lane, wave); if (it0 + G < NB * NCH * 2) ointer_item(args, it0 + G, lane, wave); }
        for (int u = bx; u < 256; u += G) skinny_out(args, lds, u, lane, wave);
    }
    SEAM(4);
    if (IN(5)) {
        pg8::Gemm g{(const pg8::bf16_t*)(ws + WS_YM), (const pg8::bf16_t*)(ws + WS_WOUT), MROWS, D, D}; pg8::StaticOrder S; S.init(ROWS_REAL, D, G, bx);
        pg8::EpiOut E{args.x_prompt, args.meta, args.x_sample, (bf16*)(ws + WS_HB), (float*)(ws + OFF_SS2)};
        pg8::gemm_phase<pg8::EpiOut, pg8::StaticOrder, true, true>(lds, g, S, E);
        for (int u = bx; u < 256; u += G) skinny_up(args, lds, u, lane, wave);
    }
    SEAM(5);
    if (IN(6)) {
        pg8::Gemm g{(const pg8::bf16_t*)(ws + WS_HB), (const pg8::bf16_t*)(ws + WS_WUP), MROWS, FF, D}; pg8::StaticOrder S; S.init(ROWS_REAL, FF, G, bx);
        pg8::EpiUp E{(bf16*)(ws + WS_HID), (const float*)(ws + OFF_SS2)};
        pg8::gemm_phase<pg8::EpiUp, pg8::StaticOrder, true, true>(lds, g, S, E);
        for (int u = bx; u < 256; u += G) skinny_down(args, lds, u, lane, wave);
    }
    SEAM(6);
    if (IN(7)) {
        if (G == 256) final_norm(args, lane, wave, ROWS_REAL);
        pg8::Gemm g{(const pg8::bf16_t*)(ws + WS_HID), (const pg8::bf16_t*)(ws + WS_WDN), MROWS, D, FF}; pg8::StaticOrder S; S.init(ROWS_REAL, D, G, bx);
        if (G == 256) { pg8::EpiDownF E{(const bf16*)(ws + WS_HB), args.out + O_YP, (float*)(ws + OFF_SS3), (unsigned*)(ws + OFF_CNT), args.final_g};
            pg8::gemm_phase<pg8::EpiDownF, pg8::StaticOrder, false, true>(lds, g, S, E); }
        else { pg8::EpiDown E{(const bf16*)(ws + WS_HB), args.out + O_YP, args.out + O_YS, (float*)(ws + OFF_SS3)};
            pg8::gemm_phase<pg8::EpiDown, pg8::StaticOrder, true, true>(lds, g, S, E); }
    }
    if (G != 256) { SEAM(7); if (IN(8)) { final_norm(args, lane, wave, 0); } }
    if (PROBE_B > PROBE_A) { STAMP(9); if (bx == PROBE_BLK && tid == 0) { const unsigned long long t0 = __builtin_amdgcn_s_memrealtime(), want = 4ull * (ts_b - ts_a); while (__builtin_amdgcn_s_memrealtime() - t0 < want) __builtin_amdgcn_s_sleep(8); } }
#undef IN
#undef SEAM
}

#ifndef N_LAUNCH_MODE
#define N_LAUNCH_MODE 1
#endif
extern "C" void kernel_launch(void* const* d_in, const int* in_sizes, int n_in, void* d_out, int out_size, void* d_ws, size_t ws_size, hipStream_t stream) {
    static int grid = 0;
    if (grid == 0) {
        int dev = 0, cus = 0, per_cu = 0;
        hipGetDevice(&dev); hipDeviceGetAttribute(&cus, hipDeviceAttributeMultiprocessorCount, dev);
        hipFuncSetAttribute((const void*)hymba_fwd, hipFuncAttributeMaxDynamicSharedMemorySize, LDS_BYTES);
        hipOccupancyMaxActiveBlocksPerMultiprocessor(&per_cu, (const void*)hymba_fwd, NTHR, LDS_BYTES);
        if (per_cu < 1) per_cu = 1;
        grid = cus * per_cu;
        if (ws_size < WS_END || n_in != 18) { fprintf(stderr, "kernel_launch: ws %zu < %zu or n_in %d\n", ws_size, (size_t)WS_END, n_in); }
        fprintf(stderr, "kernel_launch: grid %d (cus %d x %d)\n", grid, cus, per_cu);
    }
    Args a{};
    const float** pp = (const float**)&a;
    for (int i = 0; i < 18; ++i) pp[i] = (const float*)d_in[i];
    a.out = (float*)d_out; a.ws = (unsigned char*)d_ws; a.pad = 0;
#if N_LAUNCH_MODE == 1
    a.ph_lo = 0; a.ph_hi = 9; a.coop = 1;
    hipMemsetAsync((char*)d_ws + OFF_BAR, 0, BAR_BYTES, stream);
    void* kargs[] = {&a};
    hipError_t e = hipLaunchCooperativeKernel((const void*)hymba_fwd, dim3(grid), dim3(NTHR), kargs, LDS_BYTES, stream);
    if (e != hipSuccess) fprintf(stderr, "cooperative launch failed: %s (grid %d)\n", hipGetErrorString(e), grid);
#else
#ifndef DUP_MASK
#define DUP_MASK 0
#endif
    for (int p = 0; p < 9; ++p) for (int r = 0; r < 1 + ((DUP_MASK >> p) & 1); ++r) { a.ph_lo = p; a.ph_hi = p + 1; a.coop = 0; hipLaunchKernelGGL(hymba_fwd, dim3(grid), dim3(NTHR), LDS_BYTES, stream, a); }
#endif
}
```
